# Optimizing an MI355X kernel written in HIP

```python
import jax, jax.numpy as jnp
from jax import lax
import numpy as np

D_MODEL = 1024
BATCH = 8
SEQ = 8192
DEPTH = 1
DEC_BATCH = 8
DEC_SEQ = 64
PAST_LEN = 1024

CHUNK = 64
Q_BLOCK = 128
MLA_HEADS = 8
MLA_NOPE = 64
MLA_ROPE = 32
MLA_QK = MLA_NOPE + MLA_ROPE
MLA_V = 64
MLA_Q_RANK = 384
MLA_KV_RANK = 256
ROPE_THETA = 10000.0
GLA_HEADS = 4
GLA_DK = 64
GLA_DV = 128
GLA_GATE_RANK = 16
GLA_TAU = 16.0
MIX_WIDTH = MLA_HEADS * MLA_V + GLA_HEADS * GLA_DV
FFN_DIM = 2816
CONV_W = 3
EPS = 1e-6
COL_SIZES = (MLA_Q_RANK, MLA_KV_RANK, MLA_ROPE, GLA_HEADS * GLA_DK, GLA_HEADS * GLA_DK,
             GLA_HEADS * GLA_DV, GLA_GATE_RANK, GLA_HEADS * GLA_DV)
IN_COLS = (MLA_Q_RANK + MLA_KV_RANK + MLA_ROPE + 2 * GLA_HEADS * GLA_DK
           + GLA_HEADS * GLA_DV + GLA_GATE_RANK + GLA_HEADS * GLA_DV)

kernel_name = 'hybrid_mla_gla_convffn_stream_step'


def _rms(x, g):
    xf = x.astype(jnp.float32)
    y = xf * lax.rsqrt(jnp.mean(xf * xf, axis=-1, keepdims=True) + EPS)
    return (y * g.astype(jnp.float32)).astype(x.dtype)


def _rope(x, pos):
    half = MLA_ROPE // 2
    inv = 1.0 / (ROPE_THETA ** (jnp.arange(half, dtype=jnp.float32) / half))
    ang = pos.astype(jnp.float32)[:, None] * inv[None, :]
    cos = jnp.cos(ang)[None, :, None, :]
    sin = jnp.sin(ang)[None, :, None, :]
    xr = x[..., MLA_NOPE:].astype(jnp.float32)
    x1, x2 = xr[..., :half], xr[..., half:]
    rot = jnp.concatenate([x1 * cos - x2 * sin, x2 * cos + x1 * sin], axis=-1).astype(x.dtype)
    return jnp.concatenate([x[..., :MLA_NOPE], rot], axis=-1)


def _split_cols(p):
    out, o = [], 0
    for n in COL_SIZES:
        out.append(p[..., o:o + n])
        o += n
    return out


def _adaln(c, w_ada, b_ada):
    return jnp.split(jax.nn.silu(c) @ w_ada + b_ada, 6, axis=-1)


def _modulate(x, g, shift, scale):
    return _rms(x, g) * (1.0 + scale[:, None, :]) + shift[:, None, :]


def _mla_queries(q_lat, pos, g_qa, w_uq, g_qn):
    B, L, _ = q_lat.shape
    q = (_rms(q_lat, g_qa) @ w_uq).reshape(B, L, MLA_HEADS, MLA_QK)
    return _rope(_rms(q, g_qn), pos)


def _mla_keys(ckv, kpe, pos, w_ukv, g_kn):
    B, L, _ = ckv.shape
    kv = (ckv @ w_ukv).reshape(B, L, MLA_HEADS, MLA_NOPE + MLA_V)
    k_nope, v = kv[..., :MLA_NOPE], kv[..., MLA_NOPE:]
    k_pe = jnp.broadcast_to(kpe[:, :, None, :], (B, L, MLA_HEADS, MLA_ROPE)).astype(k_nope.dtype)
    k = jnp.concatenate([k_nope, k_pe], axis=-1)
    return _rope(_rms(k, g_kn), pos), v


def _attend(q, k, v, q_pos, k_pos):
    s = jnp.einsum('bqhd,bkhd->bhqk', q, k, preferred_element_type=jnp.float32) * (MLA_QK ** -0.5)
    visible = (k_pos[None, :] // CHUNK) <= (q_pos[:, None] // CHUNK)
    s = jnp.where(visible[None, None], s, jnp.finfo(jnp.float32).min)
    p = jax.nn.softmax(s, axis=-1).astype(v.dtype)
    return jnp.einsum('bhqk,bkhd->bqhd', p, v)


def _gla_log_forget(g_lr, w_a2, b_a2):
    z = (g_lr @ w_a2 + b_a2).astype(jnp.float32)
    return jax.nn.log_sigmoid(z) / GLA_TAU


def _gla_chunk(q, k, v, lg, s0):
    q, k, v = (t.astype(jnp.float32) for t in (q, k, v))
    L = q.shape[2]
    b = jnp.cumsum(lg, axis=2)
    causal = jnp.tril(jnp.ones((L, L), dtype=bool))
    diff = b[:, :, :, None, :] - b[:, :, None, :, :]
    decay = jnp.exp(jnp.where(causal[None, None, :, :, None], diff, -jnp.inf))
    a = jnp.einsum('bhid,bhjd,bhijd->bhij', q, k, decay)
    o = (jnp.einsum('bhij,bhje->bhie', a, v)
         + jnp.einsum('bhid,bhde->bhie', q * jnp.exp(b), s0))
    b_last = b[:, :, -1, :]
    s = (jnp.exp(b_last)[..., None] * s0
         + jnp.einsum('bhjd,bhje->bhde', k * jnp.exp(b_last[:, :, None, :] - b), v))
    return o, s


def _conv_ffn(h, hist, p):
    L = h.shape[1]
    a, g = jnp.split(h @ p['w_up'], 2, axis=-1)
    a_ext = jnp.concatenate([hist.astype(a.dtype), a], axis=1)
    conv = p['b_conv']
    for j in range(CONV_W):
        conv = conv + p['w_conv'][j] * a_ext[:, j:j + L]
    y = (jax.nn.gelu(conv) * g) @ p['w_down']
    return y, a_ext[:, L:]


def _mixer_inputs(x, c, p):
    B, L, _ = x.shape
    mods = _adaln(c, p['w_ada'], p['b_ada'])
    h = _modulate(x, p['g_norm1'], mods[0], mods[1])
    q_lat, kv_lat, kpe, gq, gk, gv, g_lr, og = _split_cols(h @ p['w_in'])
    ckv = _rms(kv_lat, p['g_kva'])
    gla = (gq.reshape(B, L, GLA_HEADS, GLA_DK) * (GLA_DK ** -0.5),
           gk.reshape(B, L, GLA_HEADS, GLA_DK),
           gv.reshape(B, L, GLA_HEADS, GLA_DV),
           _gla_log_forget(g_lr, p['w_a2'], p['b_a2']).reshape(B, L, GLA_HEADS, GLA_DK))
    return mods, q_lat, ckv, kpe, gla, og


def _layer_out(x, o_mla, o_gla, og, mods, conv_hist, p):
    B, L, _ = x.shape
    o_gla = _rms(o_gla.astype(x.dtype), p['g_gla']) * jax.nn.silu(og.reshape(B, L, GLA_HEADS, GLA_DV))
    mixed = jnp.concatenate([o_mla.reshape(B, L, MLA_HEADS * MLA_V),
                             o_gla.reshape(B, L, GLA_HEADS * GLA_DV)], axis=-1) @ p['w_out']
    x = x + mods[2][:, None, :] * mixed
    h = _modulate(x, p['g_norm2'], mods[3], mods[4])
    f, new_hist = _conv_ffn(h, conv_hist, p)
    return x + mods[5][:, None, :] * f, new_hist


def _layer_prompt(x, c, p):
    B, L, _ = x.shape
    pos = jnp.arange(L, dtype=jnp.int32)
    mods, q_lat, ckv, kpe, (gq, gk, gv, lg), og = _mixer_inputs(x, c, p)
    q = _mla_queries(q_lat, pos, p['g_qa'], p['w_uq'], p['g_qn'])
    k, v = _mla_keys(ckv, kpe, pos, p['w_ukv'], p['g_kn'])
    nb = L // Q_BLOCK
    q_blocks = q.reshape(B, nb, Q_BLOCK, MLA_HEADS, MLA_QK).swapaxes(0, 1)
    pos_blocks = pos.reshape(nb, Q_BLOCK)
    o_mla = lax.map(lambda blk: _attend(blk[0], k, v, blk[1], pos), (q_blocks, pos_blocks))
    o_mla = o_mla.swapaxes(0, 1).reshape(B, L, MLA_HEADS, MLA_V)
    nc = L // CHUNK
    to_blocks = lambda t: t.reshape(B, nc, CHUNK, GLA_HEADS, t.shape[-1]).transpose(1, 0, 3, 2, 4)
    s0 = jnp.zeros((B, GLA_HEADS, GLA_DK, GLA_DV), jnp.float32)

    def step(s, blk):
        o_b, s_new = _gla_chunk(blk[0], blk[1], blk[2], blk[3], s)
        return s_new, o_b

    s_fin, o_gla = lax.scan(step, s0, (to_blocks(gq), to_blocks(gk), to_blocks(gv), to_blocks(lg)))
    o_gla = o_gla.transpose(1, 0, 3, 2, 4).reshape(B, L, GLA_HEADS, GLA_DV)
    hist0 = jnp.zeros((B, CONV_W - 1, FFN_DIM), x.dtype)
    y, new_hist = _layer_out(x, o_mla, o_gla, og, mods, hist0, p)
    return y, ckv, kpe, s_fin, new_hist


def _layer_sample(x, c, cache_ckv, cache_kpe, s_gla, conv_hist, p):
    B, T, _ = x.shape
    P = cache_ckv.shape[1]
    q_pos = P + jnp.arange(T, dtype=jnp.int32)
    k_pos = jnp.arange(P + T, dtype=jnp.int32)
    mods, q_lat, ckv, kpe, (gq, gk, gv, lg), og = _mixer_inputs(x, c, p)
    q = _mla_queries(q_lat, q_pos, p['g_qa'], p['w_uq'], p['g_qn'])
    ckv_all = jnp.concatenate([cache_ckv.astype(ckv.dtype), ckv], axis=1)
    kpe_all = jnp.concatenate([cache_kpe.astype(kpe.dtype), kpe], axis=1)
    k, v = _mla_keys(ckv_all, kpe_all, k_pos, p['w_ukv'], p['g_kn'])
    o_mla = _attend(q, k, v, q_pos, k_pos)
    hd = lambda t: t.transpose(0, 2, 1, 3)
    o_gla, s_new = _gla_chunk(hd(gq), hd(gk), hd(gv), hd(lg), s_gla.astype(jnp.float32))
    o_gla = o_gla.transpose(0, 2, 1, 3)
    y, new_hist = _layer_out(x, o_mla, o_gla, og, mods, conv_hist, p)
    return y, ckv, kpe, s_new, new_hist


def setup_inputs(seed: int = 0) -> dict:
    key = jax.random.key(seed)
    ks = list(jax.random.split(key, 32))

    def nrm(i, shape, s=1.0):
        return jax.random.normal(ks[i], shape, jnp.float32) * s

    def gain(i, n):
        return 1.0 + nrm(i, (DEPTH, n), 0.02)

    return {
        'x_prompt': nrm(0, (BATCH, SEQ, D_MODEL)),
        'x_sample': nrm(1, (DEC_BATCH, DEC_SEQ, D_MODEL)),
        'c_prompt': nrm(2, (BATCH, D_MODEL)),
        'c_sample': nrm(3, (DEC_BATCH, D_MODEL)),
        'cache_ckv': nrm(4, (DEPTH, DEC_BATCH, PAST_LEN, MLA_KV_RANK)),
        'cache_kpe': nrm(5, (DEPTH, DEC_BATCH, PAST_LEN, MLA_ROPE)),
        'state_gla': nrm(6, (DEPTH, DEC_BATCH, GLA_HEADS, GLA_DK, GLA_DV)),
        'state_ffn_conv': nrm(7, (DEPTH, DEC_BATCH, CONV_W - 1, FFN_DIM)),
        'w_ada': nrm(8, (DEPTH, D_MODEL, 6 * D_MODEL), 0.5 * D_MODEL ** -0.5),
        'b_ada': nrm(9, (DEPTH, 6 * D_MODEL), 0.02),
        'g_norm1': gain(10, D_MODEL),
        'w_in': nrm(11, (DEPTH, D_MODEL, IN_COLS), D_MODEL ** -0.5),
        'g_qa': gain(12, MLA_Q_RANK),
        'w_uq': nrm(13, (DEPTH, MLA_Q_RANK, MLA_HEADS * MLA_QK), MLA_Q_RANK ** -0.5),
        'g_qn': gain(14, MLA_QK),
        'g_kva': gain(15, MLA_KV_RANK),
        'w_ukv': nrm(16, (DEPTH, MLA_KV_RANK, MLA_HEADS * (MLA_NOPE + MLA_V)), MLA_KV_RANK ** -0.5),
        'g_kn': gain(17, MLA_QK),
        'w_a2': nrm(18, (DEPTH, GLA_GATE_RANK, GLA_HEADS * GLA_DK), GLA_GATE_RANK ** -0.5),
        'b_a2': nrm(19, (DEPTH, GLA_HEADS * GLA_DK), 0.1),
        'g_gla': gain(20, GLA_DV),
        'w_out': nrm(21, (DEPTH, MIX_WIDTH, D_MODEL), MIX_WIDTH ** -0.5),
        'g_norm2': gain(22, D_MODEL),
        'w_up': nrm(23, (DEPTH, D_MODEL, 2 * FFN_DIM), D_MODEL ** -0.5),
        'w_conv': nrm(24, (DEPTH, CONV_W, FFN_DIM), CONV_W ** -0.5),
        'b_conv': nrm(25, (DEPTH, FFN_DIM), 0.02),
        'w_down': nrm(26, (DEPTH, FFN_DIM, D_MODEL), FFN_DIM ** -0.5),
    }


def reference(x_prompt, x_sample, c_prompt, c_sample, cache_ckv, cache_kpe, state_gla, state_ffn_conv,
              w_ada, b_ada, g_norm1, w_in, g_qa, w_uq, g_qn, g_kva, w_ukv, g_kn, w_a2, b_a2, g_gla,
              w_out, g_norm2, w_up, w_conv, b_conv, w_down):
    yp, ys = x_prompt, x_sample
    ckv_p, kpe_p, gla_p, conv_p = [], [], [], []
    ckv_s, kpe_s, gla_s, conv_s = [], [], [], []
    for l in range(DEPTH):
        p = {'w_ada': w_ada[l], 'b_ada': b_ada[l], 'g_norm1': g_norm1[l], 'w_in': w_in[l],
             'g_qa': g_qa[l], 'w_uq': w_uq[l], 'g_qn': g_qn[l], 'g_kva': g_kva[l],
             'w_ukv': w_ukv[l], 'g_kn': g_kn[l], 'w_a2': w_a2[l], 'b_a2': b_a2[l],
             'g_gla': g_gla[l], 'w_out': w_out[l], 'g_norm2': g_norm2[l], 'w_up': w_up[l],
             'w_conv': w_conv[l], 'b_conv': b_conv[l], 'w_down': w_down[l]}
        yp, a, b, s, h = _layer_prompt(yp, c_prompt, p)
        ckv_p.append(a); kpe_p.append(b); gla_p.append(s); conv_p.append(h)
        ys, a, b, s, h = _layer_sample(ys, c_sample, cache_ckv[l], cache_kpe[l], state_gla[l],
                                       state_ffn_conv[l], p)
        ckv_s.append(a); kpe_s.append(b); gla_s.append(s); conv_s.append(h)
    return (yp, ys, jnp.stack(ckv_p), jnp.stack(kpe_p), jnp.stack(gla_p), jnp.stack(conv_p),
            jnp.stack(ckv_s), jnp.stack(kpe_s), jnp.stack(gla_s), jnp.stack(conv_s))
```

```cpp
#include <hip/hip_runtime.h>
#include <hip/hip_cooperative_groups.h>
#include <cstdio>
namespace cg = cooperative_groups;

typedef unsigned short u16;
typedef unsigned int u32;
using bf16x8 = __attribute__((ext_vector_type(8))) short;
using f32x4 = __attribute__((ext_vector_type(4))) float;
using f32x16 = __attribute__((ext_vector_type(16))) float;
typedef __bf16 bf2_t __attribute__((ext_vector_type(2)));
typedef float fl2_t __attribute__((ext_vector_type(2)));
#define DI __device__ __forceinline__

constexpr int NTOK = 66048;
constexpr int NPTOK = 65536;
constexpr int G3ROWS = 74240;
constexpr int PROJ_LD = 2224;
constexpr int C_KV = 384, C_KPE = 640, C_GQ = 672, C_GK = 928, C_GV = 1184, C_LR = 1696, C_OG = 1712;
constexpr float EPS = 1e-6f;

constexpr size_t O_Y = 0;
constexpr size_t O_CKVP = 67108864 + 524288;
constexpr size_t O_KPEP = O_CKVP + 16777216;
constexpr size_t O_GLAP = O_KPEP + 2097152;
constexpr size_t O_CONVP = O_GLAP + 262144;
constexpr size_t O_CKVS = O_CONVP + 45056;
constexpr size_t O_KPES = O_CKVS + 131072;
constexpr size_t O_GLAS = O_KPES + 16384;
constexpr size_t O_CONVS = O_GLAS + 262144;

constexpr size_t al256(size_t x) { return (x + 255) & ~size_t(255); }
constexpr size_t W_MODS = 0;
constexpr size_t W_ROPE = W_MODS + al256(16 * 6144 * 4);
constexpr size_t W_WIN = W_ROPE + al256(8192 * 16 * 8);
constexpr size_t W_WUQ = W_WIN + al256((size_t)2304 * 1024 * 2);
constexpr size_t W_WUKV = W_WUQ + al256((size_t)1024 * 384 * 2);
constexpr size_t W_WOUT = W_WUKV + al256((size_t)1024 * 256 * 2);
constexpr size_t W_WUP = W_WOUT + al256((size_t)1024 * 1024 * 2);
constexpr size_t W_WDN = W_WUP + al256((size_t)5632 * 1024 * 2);
constexpr size_t W_KPE = W_WDN + al256((size_t)1024 * 2816 * 2);
constexpr size_t W_DBUF = W_KPE + al256((size_t)G3ROWS * 32 * 4);
constexpr size_t W_H = W_DBUF + al256((size_t)4096 * 64 * 4);
constexpr size_t W_RA = W_H + al256((size_t)NTOK * 1024 * 2);
constexpr size_t W_PROJ = W_RA;
constexpr size_t W_QN = W_PROJ + al256((size_t)NTOK * PROJ_LD * 2);
constexpr size_t W_CKVB = W_QN + al256((size_t)NTOK * 384 * 2);
constexpr size_t W_RA_END = W_CKVB + al256((size_t)G3ROWS * 256 * 2);
constexpr size_t W_ACT = W_RA;
constexpr size_t W_RB = W_RA_END;
constexpr size_t W_QF = W_RB;
constexpr size_t W_KF = W_QF + al256((size_t)NTOK * 768 * 2);
constexpr size_t W_VTP = W_KF + al256((size_t)8 * G3ROWS * 96 * 2);
constexpr size_t W_VTS = W_VTP + al256((size_t)64 * 64 * 8192 * 2);
constexpr size_t W_RB_END = W_VTS + al256((size_t)64 * 64 * 1088 * 2);
constexpr size_t W_X1 = W_RB;
constexpr size_t W_U = W_RB_END;
constexpr size_t W_FIRST = W_U;
constexpr size_t W_LAST = W_FIRST + al256((size_t)1032 * 2 * 2816 * 2 * 4);
constexpr size_t W_END = W_U + (size_t)4096 * 8192 * 4;
static_assert(W_ACT + (size_t)NTOK * 2816 * 2 <= W_RA_END, "act alias");
static_assert(W_X1 + (size_t)NTOK * 1024 * 4 <= W_RB_END, "x1 alias");
static_assert(W_LAST + (size_t)1032 * 2 * 2816 * 4 <= W_END, "first/last alias");
static_assert(W_END <= (size_t)1073741824, "workspace");

struct P {
  const float *x_prompt, *x_sample, *c_prompt, *c_sample, *cache_ckv, *cache_kpe, *state_gla, *state_conv;
  const float *w_ada, *b_ada, *g_norm1, *w_in, *g_qa, *w_uq, *g_qn, *g_kva, *w_ukv, *g_kn, *w_a2, *b_a2, *g_gla,
      *w_out, *g_norm2, *w_up, *w_conv, *b_conv, *w_down;
  float* out;
  char* ws;
};

DI u32 pack2(float a, float b) { fl2_t v = {a, b}; bf2_t r = __builtin_convertvector(v, bf2_t); return __builtin_bit_cast(u32, r); }
DI float bflo(u32 u) { return __uint_as_float(u << 16); }
DI float bfhi(u32 u) { return __uint_as_float(u & 0xffff0000u); }
DI float wave_sum(float v) {
#pragma unroll
  for (int o = 32; o > 0; o >>= 1) v += __shfl_xor(v, o);
  return v;
}
DI int tok_seq(int r) { return r < NPTOK ? (r >> 13) : 8 + ((r - NPTOK) >> 6); }
DI int tok_pos(int r) { return r < NPTOK ? (r & 8191) : 1024 + ((r - NPTOK) & 63); }
DI int tok_g3row(int r) { return r < NPTOK ? r : NPTOK + ((r - NPTOK) >> 6) * 1088 + 1024 + ((r - NPTOK) & 63); }
DI const float* x_row(const P& p, int r) { return r < NPTOK ? p.x_prompt + (size_t)r * 1024 : p.x_sample + (size_t)(r - NPTOK) * 1024; }
DI float silu_f(float x) { return x / (1.f + __expf(-x)); }
DI float gelu_tanh(float x) {
  float u = 0.7978845608028654f * (x + 0.044715f * x * x * x);
  float th = 1.f - 2.f / (__expf(2.f * u) + 1.f);
  return 0.5f * x * (1.f + th);
}
DI void unpack8(uint4 v, float* d) {
  d[0] = bflo(v.x); d[1] = bfhi(v.x); d[2] = bflo(v.y); d[3] = bfhi(v.y);
  d[4] = bflo(v.z); d[5] = bfhi(v.z); d[6] = bflo(v.w); d[7] = bfhi(v.w);
}

DI void ph0_mods(const P& p, int unit, float* sm) {
  const int t = threadIdx.x;
  for (int i = t; i < 16 * 1024; i += 256) {
    int s = i >> 10, k = i & 1023;
    float c = (s < 8) ? p.c_prompt[s * 1024 + k] : p.c_sample[(s - 8) * 1024 + k];
    sm[k * 16 + s] = c / (1.f + expf(-c));
  }
  __syncthreads();
  const int col = unit * 64 + (t & 63), kq = t >> 6;
  float acc[16];
#pragma unroll
  for (int s = 0; s < 16; ++s) acc[s] = 0.f;
  for (int k = kq * 256; k < kq * 256 + 256; ++k) {
    float w = p.w_ada[(size_t)k * 6144 + col];
    const float4* sp = (const float4*)(sm + k * 16);
    float4 a0 = sp[0], a1 = sp[1], a2 = sp[2], a3 = sp[3];
    acc[0] += a0.x * w; acc[1] += a0.y * w; acc[2] += a0.z * w; acc[3] += a0.w * w;
    acc[4] += a1.x * w; acc[5] += a1.y * w; acc[6] += a1.z * w; acc[7] += a1.w * w;
    acc[8] += a2.x * w; acc[9] += a2.y * w; acc[10] += a2.z * w; acc[11] += a2.w * w;
    acc[12] += a3.x * w; acc[13] += a3.y * w; acc[14] += a3.z * w; acc[15] += a3.w * w;
  }
  __syncthreads();
#pragma unroll
  for (int s = 0; s < 16; ++s) sm[(kq * 16 + s) * 64 + (t & 63)] = acc[s];
  __syncthreads();
  float* mods = (float*)(p.ws + W_MODS);
  for (int i = t; i < 16 * 64; i += 256) {
    int s = i >> 6, c = i & 63;
    float v = sm[(s)*64 + c] + sm[(16 + s) * 64 + c] + sm[(32 + s) * 64 + c] + sm[(48 + s) * 64 + c] + p.b_ada[unit * 64 + c];
    mods[s * 6144 + unit * 64 + c] = v;
  }
  __syncthreads();
}

DI void ph0_transpose(const float* __restrict__ W, int K, int N, u16* __restrict__ Wt, int mode, int kt, int nt, float* sm) {
  const int t = threadIdx.x;
  const int n0 = nt * 64, k0 = kt * 64;
  int src0, nvalid = 64;
  if (mode == 0) { src0 = n0; nvalid = N - n0; }
  else if (mode == 1) { int h = n0 >> 7, c = n0 & 127; src0 = h * 96 + c; nvalid = 96 - c; }
  else { int j = n0 >> 7, c = n0 & 127; src0 = (c < 64) ? j * 64 : 2816 + j * 64; }
  const int col = t & 63;
#pragma unroll
  for (int i = 0; i < 16; ++i) {
    int k = (t >> 6) + 4 * i;
    float v = (col < nvalid) ? W[(size_t)(k0 + k) * N + src0 + col] : 0.f;
    sm[k * 65 + col] = v;
  }
  __syncthreads();
#pragma unroll
  for (int i = 0; i < 2; ++i) {
    int id = t + 256 * i, n = id >> 3, kc = id & 7;
    const float* s = sm + (kc * 8) * 65 + n;
    uint4 o;
    o.x = pack2(s[0], s[65]); o.y = pack2(s[130], s[195]); o.z = pack2(s[260], s[325]); o.w = pack2(s[390], s[455]);
    *(uint4*)(Wt + (size_t)(n0 + n) * K + k0 + kc * 8) = o;
  }
  __syncthreads();
}

DI void phase0(const P& p, char* smem) {
  float* sm = (float*)smem;
  const int t = threadIdx.x;
  constexpr int U_MODS = 96, U_WIN = 576, U_WUQ = 96, U_WUKV = 64, U_WOUT = 256, U_WUP = 1408, U_WDN = 704, U_CKV = 128, U_KPE = 16, U_ROPE = 8;
  constexpr int TOTAL = U_MODS + U_WIN + U_WUQ + U_WUKV + U_WOUT + U_WUP + U_WDN + U_CKV + U_KPE + U_ROPE;
  for (int u0 = blockIdx.x; u0 < TOTAL; u0 += gridDim.x) {
    int u = u0;
    if (u < U_MODS) { ph0_mods(p, u, sm); continue; }
    u -= U_MODS;
    if (u < U_WIN) { ph0_transpose(p.w_in, 1024, 2224, (u16*)(p.ws + W_WIN), 0, u / 36, u % 36, sm); continue; }
    u -= U_WIN;
    if (u < U_WUQ) { ph0_transpose(p.w_uq, 384, 768, (u16*)(p.ws + W_WUQ), 1, u / 16, u % 16, sm); continue; }
    u -= U_WUQ;
    if (u < U_WUKV) { ph0_transpose(p.w_ukv, 256, 1024, (u16*)(p.ws + W_WUKV), 0, u / 16, u % 16, sm); continue; }
    u -= U_WUKV;
    if (u < U_WOUT) { ph0_transpose(p.w_out, 1024, 1024, (u16*)(p.ws + W_WOUT), 0, u / 16, u % 16, sm); continue; }
    u -= U_WOUT;
    if (u < U_WUP) { ph0_transpose(p.w_up, 1024, 5632, (u16*)(p.ws + W_WUP), 2, u / 88, u % 88, sm); continue; }
    u -= U_WUP;
    if (u < U_WDN) { ph0_transpose(p.w_down, 2816, 1024, (u16*)(p.ws + W_WDN), 0, u / 16, u % 16, sm); continue; }
    u -= U_WDN;
    if (u < U_CKV) {
      u16* ckvb = (u16*)(p.ws + W_CKVB);
#pragma unroll
      for (int i = 0; i < 8; ++i) {
        int id = t + 256 * i;
        int row = u * 64 + (id >> 5), c8 = id & 31;
        int sb = row >> 10, pp = row & 1023;
        const float4* src = (const float4*)(p.cache_ckv + (size_t)row * 256 + c8 * 8);
        float4 a = src[0], b = src[1];
        uint4 o = {pack2(a.x, a.y), pack2(a.z, a.w), pack2(b.x, b.y), pack2(b.z, b.w)};
        *(uint4*)(ckvb + (size_t)(NPTOK + sb * 1088 + pp) * 256 + c8 * 8) = o;
      }
      continue;
    }
    u -= U_CKV;
    if (u < U_KPE) {
      float* kpa = (float*)(p.ws + W_KPE);
#pragma unroll
      for (int i = 0; i < 16; ++i) {
        int id = t + 256 * i;
        int row = u * 512 + (id >> 3), c4 = id & 7;
        int sb = row >> 10, pp = row & 1023;
        float4 v = *(const float4*)(p.cache_kpe + (size_t)row * 32 + c4 * 4);
        *(float4*)(kpa + (size_t)(NPTOK + sb * 1088 + pp) * 32 + c4 * 4) = v;
      }
      continue;
    }
    u -= U_KPE;
    {
      float2* rope = (float2*)(p.ws + W_ROPE);
      for (int i = 0; i < 64; ++i) {
        int e = u * 16384 + i * 256 + t;
        int pos = e >> 4, idx = e & 15;
        int q = idx >> 2, r = idx & 3;
        float base = (r == 0) ? 1.f : (r == 1) ? 0.5623413251903491f : (r == 2) ? 0.31622776601683794f : 0.1778279410038923f;
        float sc = (q == 0) ? 1.f : (q == 1) ? 0.1f : (q == 2) ? 0.01f : 0.001f;
        float inv = base * sc;
        float ang = (float)pos * inv;
        double rev = (double)ang * 0.15915494309189535;
        rev -= floor(rev);
        float fr = (float)rev;
        rope[e] = make_float2(__builtin_amdgcn_cosf(fr), __builtin_amdgcn_sinf(fr));
      }
    }
  }
}

DI void prenorm_phase(const P& p, bool from_x1, const float* __restrict__ g, int shift_idx, int scale_idx) {
  const int lane = threadIdx.x & 63, wave = threadIdx.x >> 6;
  const float* mods = (const float*)(p.ws + W_MODS);
  u16* hb = (u16*)(p.ws + W_H);
  const float* x1 = (const float*)(p.ws + W_X1);
  for (int r = blockIdx.x * 4 + wave; r < NTOK; r += gridDim.x * 4) {
    const float* xr = from_x1 ? x1 + (size_t)r * 1024 : x_row(p, r);
    const int s = tok_seq(r);
    float4 v[4];
    float ss = 0.f;
#pragma unroll
    for (int i = 0; i < 4; ++i) {
      v[i] = ((const float4*)xr)[lane + 64 * i];
      ss += v[i].x * v[i].x + v[i].y * v[i].y + v[i].z * v[i].z + v[i].w * v[i].w;
    }
    ss = wave_sum(ss);
    const float rstd = rsqrtf(ss * (1.f / 1024.f) + EPS);
#pragma unroll
    for (int i = 0; i < 4; ++i) {
      int col = (lane + 64 * i) * 4;
      float4 gg = *(const float4*)(g + col);
      float4 sc = *(const float4*)(mods + s * 6144 + scale_idx * 1024 + col);
      float4 sh = *(const float4*)(mods + s * 6144 + shift_idx * 1024 + col);
      float a = v[i].x * rstd * gg.x * (1.f + sc.x) + sh.x;
      float b = v[i].y * rstd * gg.y * (1.f + sc.y) + sh.y;
      float c = v[i].z * rstd * gg.z * (1.f + sc.z) + sh.z;
      float d = v[i].w * rstd * gg.w * (1.f + sc.w) + sh.w;
      uint2 o = {pack2(a, b), pack2(c, d)};
      *(uint2*)(hb + (size_t)r * 1024 + col) = o;
    }
  }
}

constexpr int LDSK = 72;
constexpr int CTS = 132;

template <class Epi>
DI void gemm_phase(const u16* __restrict__ A, int lda, const u16* __restrict__ Bt, int K, int mtiles, int ntiles, const Epi& epi,
                   char* smem, int rot) {
  u16* As = (u16*)smem;
  u16* Bs = As + 2 * 128 * LDSK;
  float* Ct = (float*)smem;
  const int t = threadIdx.x, lane = t & 63, wave = t >> 6, wm = wave >> 1, wn = wave & 1;
  const int fr = lane & 15, fq = lane >> 4;
  const int nk = K >> 6;
  const int total = mtiles * ntiles;
  const int G = gridDim.x;
  int start = ((int)blockIdx.x - (rot % G) + G) % G;
  for (int item = start; item < total; item += G) {
    const int mt = item / ntiles, nt = item - mt * ntiles;
    const u16* Ag = A + (size_t)(mt * 128) * lda;
    const u16* Bg = Bt + (size_t)(nt * 128) * K;
    f32x4 acc[4][4];
#pragma unroll
    for (int i = 0; i < 4; ++i)
#pragma unroll
      for (int j = 0; j < 4; ++j) acc[i][j] = f32x4{0.f, 0.f, 0.f, 0.f};
    uint4 ra[4], rb[4];
#pragma unroll
    for (int i = 0; i < 4; ++i) {
      int id = t + 256 * i, row = id >> 3, kc = id & 7;
      ra[i] = *(const uint4*)(Ag + (size_t)row * lda + kc * 8);
      rb[i] = *(const uint4*)(Bg + (size_t)row * K + kc * 8);
    }
#pragma unroll
    for (int i = 0; i < 4; ++i) {
      int id = t + 256 * i, row = id >> 3, kc = id & 7;
      *(uint4*)(As + row * LDSK + kc * 8) = ra[i];
      *(uint4*)(Bs + row * LDSK + kc * 8) = rb[i];
    }
    __syncthreads();
    for (int kt = 0; kt < nk; ++kt) {
      const bool more = (kt + 1 < nk);
      if (more) {
#pragma unroll
        for (int i = 0; i < 4; ++i) {
          int id = t + 256 * i, row = id >> 3, kc = id & 7;
          ra[i] = *(const uint4*)(Ag + (size_t)row * lda + (kt + 1) * 64 + kc * 8);
          rb[i] = *(const uint4*)(Bg + (size_t)row * K + (kt + 1) * 64 + kc * 8);
        }
      }
      const u16* as = As + (kt & 1) * 128 * LDSK;
      const u16* bs = Bs + (kt & 1) * 128 * LDSK;
#pragma unroll
      for (int ks = 0; ks < 2; ++ks) {
        bf16x8 af[4], bfr[4];
#pragma unroll
        for (int i = 0; i < 4; ++i) af[i] = *(const bf16x8*)(as + (wm * 64 + i * 16 + fr) * LDSK + ks * 32 + fq * 8);
#pragma unroll
        for (int i = 0; i < 4; ++i) bfr[i] = *(const bf16x8*)(bs + (wn * 64 + i * 16 + fr) * LDSK + ks * 32 + fq * 8);
#pragma unroll
        for (int i = 0; i < 4; ++i)
#pragma unroll
          for (int j = 0; j < 4; ++j) acc[i][j] = __builtin_amdgcn_mfma_f32_16x16x32_bf16(af[i], bfr[j], acc[i][j], 0, 0, 0);
      }
      if (more) {
        u16* aw = As + ((kt + 1) & 1) * 128 * LDSK;
        u16* bw = Bs + ((kt + 1) & 1) * 128 * LDSK;
#pragma unroll
        for (int i = 0; i < 4; ++i) {
          int id = t + 256 * i, row = id >> 3, kc = id & 7;
          *(uint4*)(aw + row * LDSK + kc * 8) = ra[i];
          *(uint4*)(bw + row * LDSK + kc * 8) = rb[i];
        }
      }
      __syncthreads();
    }
#pragma unroll
    for (int i = 0; i < 4; ++i)
#pragma unroll
      for (int j = 0; j < 4; ++j)
#pragma unroll
        for (int e = 0; e < 4; ++e) Ct[(wm * 64 + i * 16 + fq * 4 + e) * CTS + wn * 64 + j * 16 + fr] = acc[i][j][e];
    __syncthreads();
    epi(mt, nt, Ct);
    __syncthreads();
  }
}

struct EpiProj {
  u16* proj;
  DI void operator()(int mt, int nt, const float* Ct) const {
    const int t = threadIdx.x;
#pragma unroll
    for (int i = 0; i < 8; ++i) {
      int id = t + 256 * i, row = id >> 4, c8 = id & 15;
      int col = nt * 128 + c8 * 8;
      if (col < PROJ_LD) {
        const float* c = Ct + row * CTS + c8 * 8;
        float4 a = *(const float4*)c, b = *(const float4*)(c + 4);
        uint4 o = {pack2(a.x, a.y), pack2(a.z, a.w), pack2(b.x, b.y), pack2(b.z, b.w)};
        *(uint4*)(proj + (size_t)(mt * 128 + row) * PROJ_LD + col) = o;
      }
    }
  }
};

struct EpiQ {
  u16* Qf; const float* g_qn; const float2* rope;
  DI void operator()(int mt, int nt, const float* Ct) const {
    const int t = threadIdx.x, row = t >> 1, half = t & 1;
    const int r = mt * 128 + row;
    const float QS = 0.14724445f;
    const float* c = Ct + row * CTS + half * 48;
    float v[48];
    float ss = 0.f;
#pragma unroll
    for (int i = 0; i < 12; ++i) {
      float4 x = *(const float4*)(c + 4 * i);
      v[4 * i] = x.x; v[4 * i + 1] = x.y; v[4 * i + 2] = x.z; v[4 * i + 3] = x.w;
      ss += x.x * x.x + x.y * x.y + x.z * x.z + x.w * x.w;
    }
    ss += __shfl_xor(ss, 1);
    const float rs = rsqrtf(ss * (1.f / 96.f) + EPS) * QS;
    u16* dst = Qf + ((size_t)r * 8 + nt) * 96 + half * 48;
    if (half == 0) {
#pragma unroll
      for (int i = 0; i < 48; ++i) v[i] = v[i] * rs * g_qn[i];
    } else {
      const int pos = tok_pos(r);
#pragma unroll
      for (int i = 0; i < 16; ++i) v[i] = v[i] * rs * g_qn[48 + i];
#pragma unroll
      for (int m = 0; m < 16; ++m) {
        float n1 = v[16 + m] * rs * g_qn[64 + m], n2 = v[32 + m] * rs * g_qn[80 + m];
        float2 cs = rope[pos * 16 + m];
        v[16 + m] = n1 * cs.x - n2 * cs.y;
        v[32 + m] = n2 * cs.x + n1 * cs.y;
      }
    }
#pragma unroll
    for (int i = 0; i < 6; ++i) {
      uint4 o = {pack2(v[8 * i], v[8 * i + 1]), pack2(v[8 * i + 2], v[8 * i + 3]), pack2(v[8 * i + 4], v[8 * i + 5]), pack2(v[8 * i + 6], v[8 * i + 7])};
      *(uint4*)(dst + 8 * i) = o;
    }
  }
};

struct EpiKV {
  u16* Kf; u16* VtP; u16* VtS; const float* kpe_all; const float* g_kn; const float2* rope;
  DI void operator()(int mt, int nt, const float* Ct) const {
    const int t = threadIdx.x, row = t >> 1, half = t & 1;
    const int r = mt * 128 + row;
    int seq, pos;
    if (r < NPTOK) { seq = r >> 13; pos = r & 8191; } else { int rr = r - NPTOK; seq = 8 + rr / 1088; pos = rr - (seq - 8) * 1088; }
    u16* dst = Kf + ((size_t)nt * G3ROWS + r) * 96;
    if (half == 0) {
      float v[64];
      float ss = 0.f;
      const float* c = Ct + row * CTS;
#pragma unroll
      for (int i = 0; i < 16; ++i) {
        float4 x = *(const float4*)(c + 4 * i);
        v[4 * i] = x.x; v[4 * i + 1] = x.y; v[4 * i + 2] = x.z; v[4 * i + 3] = x.w;
        ss += x.x * x.x + x.y * x.y + x.z * x.z + x.w * x.w;
      }
      ss += __shfl_xor(ss, 1);
      const float rs = rsqrtf(ss * (1.f / 96.f) + EPS);
#pragma unroll
      for (int i = 0; i < 8; ++i) {
        uint4 o = {pack2(v[8 * i] * rs * g_kn[8 * i], v[8 * i + 1] * rs * g_kn[8 * i + 1]),
                   pack2(v[8 * i + 2] * rs * g_kn[8 * i + 2], v[8 * i + 3] * rs * g_kn[8 * i + 3]),
                   pack2(v[8 * i + 4] * rs * g_kn[8 * i + 4], v[8 * i + 5] * rs * g_kn[8 * i + 5]),
                   pack2(v[8 * i + 6] * rs * g_kn[8 * i + 6], v[8 * i + 7] * rs * g_kn[8 * i + 7])};
        *(uint4*)(dst + 8 * i) = o;
      }
    } else {
      float v[32];
      float ss = 0.f;
      const float* c = kpe_all + (size_t)r * 32;
#pragma unroll
      for (int i = 0; i < 8; ++i) {
        float4 x = *(const float4*)(c + 4 * i);
        v[4 * i] = x.x; v[4 * i + 1] = x.y; v[4 * i + 2] = x.z; v[4 * i + 3] = x.w;
        ss += x.x * x.x + x.y * x.y + x.z * x.z + x.w * x.w;
      }
      ss += __shfl_xor(ss, 1);
      const float rs = rsqrtf(ss * (1.f / 96.f) + EPS);
#pragma unroll
      for (int m = 0; m < 16; ++m) {
        float n1 = v[m] * rs * g_kn[64 + m], n2 = v[16 + m] * rs * g_kn[80 + m];
        float2 cs = rope[pos * 16 + m];
        v[m] = n1 * cs.x - n2 * cs.y;
        v[16 + m] = n2 * cs.x + n1 * cs.y;
      }
#pragma unroll
      for (int i = 0; i < 4; ++i) {
        uint4 o = {pack2(v[8 * i], v[8 * i + 1]), pack2(v[8 * i + 2], v[8 * i + 3]), pack2(v[8 * i + 4], v[8 * i + 5]), pack2(v[8 * i + 6], v[8 * i + 7])};
        *(uint4*)(dst + 64 + 8 * i) = o;
      }
    }
#pragma unroll
    for (int i = 0; i < 4; ++i) {
      int id = t + 256 * i, rg = id & 15, vd = id >> 4;
      int r0 = mt * 128 + rg * 8;
      const float* c = Ct + (rg * 8) * CTS + 64 + vd;
      uint4 o = {pack2(c[0], c[CTS]), pack2(c[2 * CTS], c[3 * CTS]), pack2(c[4 * CTS], c[5 * CTS]), pack2(c[6 * CTS], c[7 * CTS])};
      u16* d;
      if (r0 < NPTOK) { int sq = r0 >> 13, p0 = r0 & 8191; d = VtP + ((size_t)((sq * 8 + nt) * 64 + vd)) * 8192 + p0; }
      else { int rr = r0 - NPTOK; int sb = rr / 1088; int p0 = rr - sb * 1088; d = VtS + ((size_t)((sb * 8 + nt) * 64 + vd)) * 1088 + p0; }
      *(uint4*)d = o;
    }
  }
};

struct EpiRes {
  const P* pp; const float* src_x1; float* dst; const float* mods; int gate_idx;
  DI void operator()(int mt, int nt, const float* Ct) const {
    const int t = threadIdx.x;
#pragma unroll
    for (int i = 0; i < 16; ++i) {
      int id = t + 256 * i, row = id >> 5, c4 = id & 31;
      int r = mt * 128 + row, col = nt * 128 + c4 * 4;
      int s = tok_seq(r);
      float4 a = *(const float4*)(Ct + row * CTS + c4 * 4);
      const float* sr = src_x1 ? src_x1 + (size_t)r * 1024 : x_row(*pp, r);
      float4 xv = *(const float4*)(sr + col);
      float4 g = *(const float4*)(mods + s * 6144 + gate_idx * 1024 + col);
      float4 o = {xv.x + g.x * a.x, xv.y + g.y * a.y, xv.z + g.z * a.z, xv.w + g.w * a.w};
      *(float4*)(dst + (size_t)r * 1024 + col) = o;
    }
  }
};

struct EpiUp {
  u16* act; float* first; float* last; const float* w_conv; const float* b_conv; float* out;
  DI void operator()(int mt, int nt, const float* Ct) const {
    const int t = threadIdx.x, cp = t & 31, rgp = t >> 5;
    const int ch = nt * 64 + 2 * cp;
    const float2 w0 = *(const float2*)(w_conv + ch), w1 = *(const float2*)(w_conv + 2816 + ch), w2 = *(const float2*)(w_conv + 5632 + ch);
    const float2 bb = *(const float2*)(b_conv + ch);
    const int rbase = rgp * 16;
    float2 am2 = {0.f, 0.f}, am1 = {0.f, 0.f};
    if ((rbase & 63) != 0) {
      am2 = *(const float2*)(Ct + (rbase - 2) * CTS + 2 * cp);
      am1 = *(const float2*)(Ct + (rbase - 1) * CTS + 2 * cp);
    }
#pragma unroll 4
    for (int rr = 0; rr < 16; ++rr) {
      const int row = rbase + rr;
      const float2 a = *(const float2*)(Ct + row * CTS + 2 * cp);
      const float2 g = *(const float2*)(Ct + row * CTS + 64 + 2 * cp);
      const int r = mt * 128 + row, sr = row & 63, seg = r >> 6;
      if (sr >= 2) {
        float c0 = bb.x + w0.x * am2.x + w1.x * am1.x + w2.x * a.x;
        float c1 = bb.y + w0.y * am2.y + w1.y * am1.y + w2.y * a.y;
        *(u32*)(act + (size_t)r * 2816 + ch) = pack2(gelu_tanh(c0) * g.x, gelu_tanh(c1) * g.y);
      } else {
        float4 o = {a.x, g.x, a.y, g.y};
        *(float4*)(first + ((size_t)(seg * 2 + sr) * 2816 + ch) * 2) = o;
      }
      if (sr >= 62) {
        *(float2*)(last + (size_t)(seg * 2 + (sr - 62)) * 2816 + ch) = a;
        if (seg >= 1024) *(float2*)(out + O_CONVS + (size_t)((seg - 1024) * 2 + (sr - 62)) * 2816 + ch) = a;
        else if ((seg & 127) == 127) *(float2*)(out + O_CONVP + (size_t)((seg >> 7) * 2 + (sr - 62)) * 2816 + ch) = a;
      }
      am2 = am1; am1 = a;
    }
  }
};

DI void rowlocal_phase(const P& p) {
  const int lane = threadIdx.x & 63, wave = threadIdx.x >> 6;
  const u16* proj = (const u16*)(p.ws + W_PROJ);
  u16* qn = (u16*)(p.ws + W_QN);
  u16* ckvb = (u16*)(p.ws + W_CKVB);
  float* kpa = (float*)(p.ws + W_KPE);
  for (int r = blockIdx.x * 4 + wave; r < NTOK; r += gridDim.x * 4) {
    const u16* pr = proj + (size_t)r * PROJ_LD;
    const u32* pq = (const u32*)(pr + lane * 6);
    u32 q0 = pq[0], q1 = pq[1], q2 = pq[2];
    uint2 kv = *(const uint2*)(pr + C_KV + lane * 4);
    float qv[6] = {bflo(q0), bfhi(q0), bflo(q1), bfhi(q1), bflo(q2), bfhi(q2)};
    float kk[4] = {bflo(kv.x), bfhi(kv.x), bflo(kv.y), bfhi(kv.y)};
    float sq = 0.f, sk = 0.f;
#pragma unroll
    for (int i = 0; i < 6; ++i) sq += qv[i] * qv[i];
#pragma unroll
    for (int i = 0; i < 4; ++i) sk += kk[i] * kk[i];
    sq = wave_sum(sq); sk = wave_sum(sk);
    const float rq = rsqrtf(sq * (1.f / 384.f) + EPS), rk = rsqrtf(sk * (1.f / 256.f) + EPS);
    u32* dq = (u32*)(qn + (size_t)r * 384 + lane * 6);
    const float* gq = p.g_qa + lane * 6;
    dq[0] = pack2(qv[0] * rq * gq[0], qv[1] * rq * gq[1]);
    dq[1] = pack2(qv[2] * rq * gq[2], qv[3] * rq * gq[3]);
    dq[2] = pack2(qv[4] * rq * gq[4], qv[5] * rq * gq[5]);
    float4 gk = *(const float4*)(p.g_kva + lane * 4);
    float4 cv = {kk[0] * rk * gk.x, kk[1] * rk * gk.y, kk[2] * rk * gk.z, kk[3] * rk * gk.w};
    float* co = (r < NPTOK) ? p.out + O_CKVP + (size_t)r * 256 : p.out + O_CKVS + (size_t)(r - NPTOK) * 256;
    *(float4*)(co + lane * 4) = cv;
    const int g3 = tok_g3row(r);
    uint2 cb = {pack2(cv.x, cv.y), pack2(cv.z, cv.w)};
    *(uint2*)(ckvb + (size_t)g3 * 256 + lane * 4) = cb;
    if (lane < 32) {
      float kp = __uint_as_float(((u32)pr[C_KPE + lane]) << 16);
      float* ko = (r < NPTOK) ? p.out + O_KPEP + (size_t)r * 32 : p.out + O_KPES + (size_t)(r - NPTOK) * 32;
      ko[lane] = kp;
      kpa[(size_t)g3 * 32 + lane] = kp;
    }
  }
}

constexpr int GS = 68;
DI void gla_prep(const P& p, const u16* proj, int r0, int h, float* sV, float* sS) {
  const int t = threadIdx.x;
  if (t < 128) {
    int row = t >> 1, hf = t & 1;
    uint4 v = *(const uint4*)(proj + (size_t)(r0 + row) * PROJ_LD + C_LR + hf * 8);
    unpack8(v, sV + row * 16 + hf * 8);
  }
#pragma unroll
  for (int i = 0; i < 4; ++i) {
    int id = t + 256 * i, rr = id >> 6, d = id & 63;
    sV[1024 + id] = p.w_a2[rr * 256 + h * 64 + d];
  }
  __syncthreads();
  {
    const int d = t & 63, tg = t >> 6;
    float wv[16];
#pragma unroll
    for (int rr = 0; rr < 16; ++rr) wv[rr] = sV[1024 + rr * 64 + d];
    const float bb = p.b_a2[h * 64 + d];
    for (int tt = 0; tt < 16; ++tt) {
      const int tk = tg * 16 + tt;
      const float4* gp = (const float4*)(sV + tk * 16);
      float4 g0 = gp[0], g1 = gp[1], g2 = gp[2], g3 = gp[3];
      float z = bb + g0.x * wv[0] + g0.y * wv[1] + g0.z * wv[2] + g0.w * wv[3] + g1.x * wv[4] + g1.y * wv[5] + g1.z * wv[6] + g1.w * wv[7] +
                g2.x * wv[8] + g2.y * wv[9] + g2.z * wv[10] + g2.w * wv[11] + g3.x * wv[12] + g3.y * wv[13] + g3.z * wv[14] + g3.w * wv[15];
      float ls = fminf(z, 0.f) - log1pf(expf(-fabsf(z)));
      sS[tk * GS + d] = ls * (1.f / 16.f);
    }
  }
  __syncthreads();
  if (t < 64) {
    float run = 0.f;
    for (int tk = 0; tk < 64; ++tk) { run += sS[tk * GS + t]; sS[tk * GS + t] = run; }
  }
  __syncthreads();
}

DI void gla_passA(const P& p, int item, char* smem) {
  float* sm = (float*)smem;
  float* sQV = sm;
  float* sV = sm + 4352;
  float* sK = sm + 8704;
  float* sS = sm + 13056;
  const u16* proj = (const u16*)(p.ws + W_PROJ);
  const int t = threadIdx.x;
  int r0, h;
  if (item < 4096) { int ch = item >> 7, c = item & 127; h = ch & 3; r0 = (ch >> 2) * 8192 + c * 64; }
  else { int j = item - 4096; h = j & 3; r0 = NPTOK + (j >> 2) * 64; }
  gla_prep(p, proj, r0, h, sV, sS);
#pragma unroll
  for (int i = 0; i < 8; ++i) {
    int id = t + 256 * i, row = id >> 5, dp = id & 31;
    u32 kk = *(const u32*)(proj + (size_t)(r0 + row) * PROJ_LD + C_GK + h * 64 + dp * 2);
    float bl0 = sS[63 * GS + 2 * dp], bl1 = sS[63 * GS + 2 * dp + 1];
    sK[row * GS + 2 * dp] = bflo(kk) * expf(bl0 - sS[row * GS + 2 * dp]);
    sK[row * GS + 2 * dp + 1] = bfhi(kk) * expf(bl1 - sS[row * GS + 2 * dp + 1]);
  }
  __syncthreads();
#pragma unroll
  for (int i = 0; i < 4; ++i) {
    int id = t + 256 * i, row = id >> 4, ec = id & 15;
    uint4 v = *(const uint4*)(proj + (size_t)(r0 + row) * PROJ_LD + C_GV + h * 128 + ec * 8);
    float f[8];
    unpack8(v, f);
    *(float4*)(sQV + row * 132 + ec * 8) = make_float4(f[0], f[1], f[2], f[3]);
    *(float4*)(sQV + row * 132 + ec * 8 + 4) = make_float4(f[4], f[5], f[6], f[7]);
  }
  __syncthreads();
  const int td = t >> 4, te = t & 15;
  float U[4][8];
#pragma unroll
  for (int a = 0; a < 4; ++a)
#pragma unroll
    for (int b = 0; b < 8; ++b) U[a][b] = 0.f;
#pragma unroll 2
  for (int j = 0; j < 64; ++j) {
    float4 kv = *(const float4*)(sK + j * GS + 4 * td);
    float4 v0 = *(const float4*)(sQV + j * 132 + 4 * te);
    float4 v1 = *(const float4*)(sQV + j * 132 + 64 + 4 * te);
    float kx[4] = {kv.x, kv.y, kv.z, kv.w};
#pragma unroll
    for (int a = 0; a < 4; ++a) {
      U[a][0] += kx[a] * v0.x; U[a][1] += kx[a] * v0.y; U[a][2] += kx[a] * v0.z; U[a][3] += kx[a] * v0.w;
      U[a][4] += kx[a] * v1.x; U[a][5] += kx[a] * v1.y; U[a][6] += kx[a] * v1.z; U[a][7] += kx[a] * v1.w;
    }
  }
  if (item < 4096) {
    float* Ub = (float*)(p.ws + W_U) + (size_t)item * 8192;
    float* db = (float*)(p.ws + W_DBUF) + (size_t)item * 64;
#pragma unroll
    for (int a = 0; a < 4; ++a) {
      int d = 4 * td + a;
      *(float4*)(Ub + d * 128 + 4 * te) = make_float4(U[a][0], U[a][1], U[a][2], U[a][3]);
      *(float4*)(Ub + d * 128 + 64 + 4 * te) = make_float4(U[a][4], U[a][5], U[a][6], U[a][7]);
      if (te == 0) db[d] = expf(sS[63 * GS + d]);
    }
  } else {
    const int j = item - 4096;
    const float* S0 = p.state_gla + (size_t)j * 8192;
    float* So = p.out + O_GLAS + (size_t)j * 8192;
#pragma unroll
    for (int a = 0; a < 4; ++a) {
      int d = 4 * td + a;
      float dec = expf(sS[63 * GS + d]);
      float4 s0 = *(const float4*)(S0 + d * 128 + 4 * te), s1 = *(const float4*)(S0 + d * 128 + 64 + 4 * te);
      *(float4*)(So + d * 128 + 4 * te) = make_float4(dec * s0.x + U[a][0], dec * s0.y + U[a][1], dec * s0.z + U[a][2], dec * s0.w + U[a][3]);
      *(float4*)(So + d * 128 + 64 + 4 * te) = make_float4(dec * s1.x + U[a][4], dec * s1.y + U[a][5], dec * s1.z + U[a][6], dec * s1.w + U[a][7]);
    }
  }
  __syncthreads();
}

DI void gla_passB(const P& p) {
  float* Ub = (float*)(p.ws + W_U);
  const float* db = (const float*)(p.ws + W_DBUF);
  for (int e = blockIdx.x * 256 + threadIdx.x; e < 32 * 8192; e += gridDim.x * 256) {
    const int chain = e >> 13, de = e & 8191, d = de >> 7;
    float S = 0.f;
    float* ub = Ub + (size_t)chain * 128 * 8192 + de;
    const float* dd = db + (size_t)chain * 128 * 64 + d;
#pragma unroll 8
    for (int c = 0; c < 128; ++c) {
      float u = ub[(size_t)c * 8192];
      float dec = dd[c * 64];
      ub[(size_t)c * 8192] = S;
      S = dec * S + u;
    }
    p.out[O_GLAP + e] = S;
  }
}

DI void gla_passC(const P& p, int item, char* smem) {
  float* sm = (float*)smem;
  float* sQ = sm;
  float* sV = sm + 4352;
  float* sK = sm + 8704;
  float* sS = sm + 13056;
  const u16* proj = (const u16*)(p.ws + W_PROJ);
  u16* mix = (u16*)(p.ws + W_H);
  const int t = threadIdx.x;
  int r0, h;
  const float* Ssrc;
  if (item < 4096) { int ch = item >> 7, c = item & 127; h = ch & 3; r0 = (ch >> 2) * 8192 + c * 64; Ssrc = (const float*)(p.ws + W_U) + (size_t)item * 8192; }
  else { int j = item - 4096; h = j & 3; r0 = NPTOK + (j >> 2) * 64; Ssrc = p.state_gla + (size_t)j * 8192; }
  gla_prep(p, proj, r0, h, sV, sS);
#pragma unroll
  for (int i = 0; i < 8; ++i) {
    int id = t + 256 * i, row = id >> 5, dp = id & 31;
    u32 qq = *(const u32*)(proj + (size_t)(r0 + row) * PROJ_LD + C_GQ + h * 64 + dp * 2);
    u32 kk = *(const u32*)(proj + (size_t)(r0 + row) * PROJ_LD + C_GK + h * 64 + dp * 2);
    float b0 = sS[row * GS + 2 * dp], b1 = sS[row * GS + 2 * dp + 1];
    sQ[row * GS + 2 * dp] = bflo(qq) * 0.125f * expf(b0);
    sQ[row * GS + 2 * dp + 1] = bfhi(qq) * 0.125f * expf(b1);
    sK[row * GS + 2 * dp] = bflo(kk) * expf(-b0);
    sK[row * GS + 2 * dp + 1] = bfhi(kk) * expf(-b1);
  }
  __syncthreads();
  const int ti = t >> 4, tj = t & 15;
  float A[4][4];
#pragma unroll
  for (int a = 0; a < 4; ++a)
#pragma unroll
    for (int b = 0; b < 4; ++b) A[a][b] = 0.f;
#pragma unroll 1
  for (int d4 = 0; d4 < 16; ++d4) {
    float4 q[4], k[4];
#pragma unroll
    for (int a = 0; a < 4; ++a) q[a] = *(const float4*)(sQ + (ti + 16 * a) * GS + 4 * d4);
#pragma unroll
    for (int b = 0; b < 4; ++b) k[b] = *(const float4*)(sK + (tj + 16 * b) * GS + 4 * d4);
#pragma unroll
    for (int a = 0; a < 4; ++a)
#pragma unroll
      for (int b = 0; b < 4; ++b) A[a][b] += q[a].x * k[b].x + q[a].y * k[b].y + q[a].z * k[b].z + q[a].w * k[b].w;
  }
  __syncthreads();
#pragma unroll
  for (int a = 0; a < 4; ++a)
#pragma unroll
    for (int b = 0; b < 4; ++b) sK[(ti + 16 * a) * GS + tj + 16 * b] = ((tj + 16 * b) <= (ti + 16 * a)) ? A[a][b] : 0.f;
  float o[2][4][4];
#pragma unroll
  for (int hf = 0; hf < 2; ++hf) {
#pragma unroll
    for (int i = 0; i < 2; ++i) {
      int id = t + 256 * i, row = id >> 3, ec = id & 7;
      uint4 v = *(const uint4*)(proj + (size_t)(r0 + row) * PROJ_LD + C_GV + h * 128 + hf * 64 + ec * 8);
      float f[8];
      unpack8(v, f);
      *(float4*)(sV + row * GS + ec * 8) = make_float4(f[0], f[1], f[2], f[3]);
      *(float4*)(sV + row * GS + ec * 8 + 4) = make_float4(f[4], f[5], f[6], f[7]);
    }
#pragma unroll
    for (int i = 0; i < 4; ++i) {
      int id = t + 256 * i, d = id >> 4, e4 = id & 15;
      *(float4*)(sS + d * GS + e4 * 4) = *(const float4*)(Ssrc + d * 128 + hf * 64 + e4 * 4);
    }
    __syncthreads();
#pragma unroll
    for (int a = 0; a < 4; ++a)
#pragma unroll
      for (int c = 0; c < 4; ++c) o[hf][a][c] = 0.f;
#pragma unroll 1
    for (int j4 = 0; j4 < 16; ++j4) {
      float4 av[4], vv[4];
#pragma unroll
      for (int a = 0; a < 4; ++a) av[a] = *(const float4*)(sK + (ti + 16 * a) * GS + 4 * j4);
#pragma unroll
      for (int b = 0; b < 4; ++b) vv[b] = *(const float4*)(sV + (4 * j4 + b) * GS + 4 * tj);
#pragma unroll
      for (int a = 0; a < 4; ++a) {
        o[hf][a][0] += av[a].x * vv[0].x + av[a].y * vv[1].x + av[a].z * vv[2].x + av[a].w * vv[3].x;
        o[hf][a][1] += av[a].x * vv[0].y + av[a].y * vv[1].y + av[a].z * vv[2].y + av[a].w * vv[3].y;
        o[hf][a][2] += av[a].x * vv[0].z + av[a].y * vv[1].z + av[a].z * vv[2].z + av[a].w * vv[3].z;
        o[hf][a][3] += av[a].x * vv[0].w + av[a].y * vv[1].w + av[a].z * vv[2].w + av[a].w * vv[3].w;
      }
    }
#pragma unroll 1
    for (int d4 = 0; d4 < 16; ++d4) {
      float4 av[4], vv[4];
#pragma unroll
      for (int a = 0; a < 4; ++a) av[a] = *(const float4*)(sQ + (ti + 16 * a) * GS + 4 * d4);
#pragma unroll
      for (int b = 0; b < 4; ++b) vv[b] = *(const float4*)(sS + (4 * d4 + b) * GS + 4 * tj);
#pragma unroll
      for (int a = 0; a < 4; ++a) {
        o[hf][a][0] += av[a].x * vv[0].x + av[a].y * vv[1].x + av[a].z * vv[2].x + av[a].w * vv[3].x;
        o[hf][a][1] += av[a].x * vv[0].y + av[a].y * vv[1].y + av[a].z * vv[2].y + av[a].w * vv[3].y;
        o[hf][a][2] += av[a].x * vv[0].z + av[a].y * vv[1].z + av[a].z * vv[2].z + av[a].w * vv[3].z;
        o[hf][a][3] += av[a].x * vv[0].w + av[a].y * vv[1].w + av[a].z * vv[2].w + av[a].w * vv[3].w;
      }
    }
    __syncthreads();
  }
#pragma unroll
  for (int a = 0; a < 4; ++a) {
    float ss = 0.f;
#pragma unroll
    for (int hf = 0; hf < 2; ++hf)
#pragma unroll
      for (int c = 0; c < 4; ++c) ss += o[hf][a][c] * o[hf][a][c];
    ss += __shfl_xor(ss, 1); ss += __shfl_xor(ss, 2); ss += __shfl_xor(ss, 4); ss += __shfl_xor(ss, 8);
    const float rs = rsqrtf(ss * (1.f / 128.f) + EPS);
    const int r = r0 + ti + 16 * a;
#pragma unroll
    for (int hf = 0; hf < 2; ++hf) {
      const int e = hf * 64 + 4 * tj;
      uint2 og = *(const uint2*)(proj + (size_t)r * PROJ_LD + C_OG + h * 128 + e);
      float4 gg = *(const float4*)(p.g_gla + e);
      float v0 = o[hf][a][0] * rs * gg.x * silu_f(bflo(og.x));
      float v1 = o[hf][a][1] * rs * gg.y * silu_f(bfhi(og.x));
      float v2 = o[hf][a][2] * rs * gg.z * silu_f(bflo(og.y));
      float v3 = o[hf][a][3] * rs * gg.w * silu_f(bfhi(og.y));
      uint2 w = {pack2(v0, v1), pack2(v2, v3)};
      *(uint2*)(mix + (size_t)r * 1024 + 512 + h * 128 + e) = w;
    }
  }
  __syncthreads();
}

constexpr int KST = 104, VST = 72, ABUF = 64 * KST + 64 * VST;
DI void attn_item(const P& p, int seq, int h, int qb, char* smem) {
  const u16* Qf = (const u16*)(p.ws + W_QF);
  const u16* Kf = (const u16*)(p.ws + W_KF);
  u16* mix = (u16*)(p.ws + W_H);
  u16* sm = (u16*)smem;
  const int t = threadIdx.x, lane = t & 63, wave = t >> 6, l31 = lane & 31, hh = lane >> 5;
  int ntiles, mylast, qtok0, Lk;
  const u16 *Kb, *Vb;
  if (seq < 8) {
    ntiles = qb * 4 + 4; mylast = qb * 4 + wave; qtok0 = seq * 8192 + qb * 256 + wave * 64; Lk = 8192;
    Kb = Kf + ((size_t)h * G3ROWS + seq * 8192) * 96;
    Vb = (const u16*)(p.ws + W_VTP) + (size_t)((seq * 8 + h) * 64) * 8192;
  } else {
    ntiles = 17; mylast = (wave == 0) ? 16 : -1; qtok0 = NPTOK + (seq - 8) * 64; Lk = 1088;
    Kb = Kf + ((size_t)h * G3ROWS + NPTOK + (seq - 8) * 1088) * 96;
    Vb = (const u16*)(p.ws + W_VTS) + (size_t)(((seq - 8) * 8 + h) * 64) * 1088;
  }
  bf16x8 qf[2][6];
#pragma unroll
  for (int qt = 0; qt < 2; ++qt)
#pragma unroll
    for (int ks = 0; ks < 6; ++ks) {
      if (mylast >= 0) qf[qt][ks] = *(const bf16x8*)(Qf + ((size_t)(qtok0 + qt * 32 + l31) * 8 + h) * 96 + ks * 16 + hh * 8);
      else qf[qt][ks] = bf16x8{0, 0, 0, 0, 0, 0, 0, 0};
    }
  f32x16 o[2][2];
#pragma unroll
  for (int a = 0; a < 2; ++a)
#pragma unroll
    for (int b = 0; b < 2; ++b)
#pragma unroll
      for (int e = 0; e < 16; ++e) o[a][b][e] = 0.f;
  float lsum[2] = {0.f, 0.f};
  const int kid0 = t, kid1 = t + 256, kid2 = t + 512;
  const int krow0 = kid0 / 12, krow1 = kid1 / 12, krow2 = kid2 / 12;
  const int kso0 = krow0 * KST + (kid0 - krow0 * 12) * 8, kso1 = krow1 * KST + (kid1 - krow1 * 12) * 8, kso2 = krow2 * KST + (kid2 - krow2 * 12) * 8;
  const int vd0 = t >> 3, vd1 = (t + 256) >> 3, vch = t & 7;
  const int vso0 = 64 * KST + vd0 * VST + vch * 8, vso1 = 64 * KST + vd1 * VST + vch * 8;
  const u16* vg0 = Vb + (size_t)vd0 * Lk + vch * 8;
  const u16* vg1 = Vb + (size_t)vd1 * Lk + vch * 8;
  uint4 kr0, kr1, kr2, vr0, vr1;
  kr0 = *(const uint4*)(Kb + (size_t)kid0 * 8); kr1 = *(const uint4*)(Kb + (size_t)kid1 * 8); kr2 = *(const uint4*)(Kb + (size_t)kid2 * 8);
  vr0 = *(const uint4*)vg0; vr1 = *(const uint4*)vg1;
  *(uint4*)(sm + kso0) = kr0; *(uint4*)(sm + kso1) = kr1; *(uint4*)(sm + kso2) = kr2;
  *(uint4*)(sm + vso0) = vr0; *(uint4*)(sm + vso1) = vr1;
  __syncthreads();
  for (int kt = 0; kt < ntiles; ++kt) {
    const bool more = (kt + 1 < ntiles);
    if (more) {
      const u16* kg = Kb + (size_t)(kt + 1) * 64 * 96;
      kr0 = *(const uint4*)(kg + (size_t)kid0 * 8); kr1 = *(const uint4*)(kg + (size_t)kid1 * 8); kr2 = *(const uint4*)(kg + (size_t)kid2 * 8);
      vr0 = *(const uint4*)(vg0 + (kt + 1) * 64); vr1 = *(const uint4*)(vg1 + (kt + 1) * 64);
    }
    if (kt <= mylast) {
      const u16* Ks = sm + (kt & 1) * ABUF;
      const u16* Vs = Ks + 64 * KST;
#pragma unroll 1
      for (int sub = 0; sub < 2; ++sub) {
        f32x16 s0, s1;
#pragma unroll
        for (int e = 0; e < 16; ++e) { s0[e] = 0.f; s1[e] = 0.f; }
#pragma unroll
        for (int ks = 0; ks < 6; ++ks) {
          bf16x8 kf = *(const bf16x8*)(Ks + (sub * 32 + l31) * KST + ks * 16 + hh * 8);
          s0 = __builtin_amdgcn_mfma_f32_32x32x16_bf16(kf, qf[0][ks], s0, 0, 0, 0);
          s1 = __builtin_amdgcn_mfma_f32_32x32x16_bf16(kf, qf[1][ks], s1, 0, 0, 0);
        }
        uint4 pk0[2], pk1[2];
        {
          float e0[16], e1[16];
#pragma unroll
          for (int e = 0; e < 16; ++e) {
            e0[e] = __builtin_amdgcn_exp2f(s0[e]); e1[e] = __builtin_amdgcn_exp2f(s1[e]);
            lsum[0] += e0[e]; lsum[1] += e1[e];
          }
#pragma unroll
          for (int kk = 0; kk < 2; ++kk) {
            pk0[kk] = uint4{pack2(e0[8 * kk], e0[8 * kk + 1]), pack2(e0[8 * kk + 2], e0[8 * kk + 3]), pack2(e0[8 * kk + 4], e0[8 * kk + 5]), pack2(e0[8 * kk + 6], e0[8 * kk + 7])};
            pk1[kk] = uint4{pack2(e1[8 * kk], e1[8 * kk + 1]), pack2(e1[8 * kk + 2], e1[8 * kk + 3]), pack2(e1[8 * kk + 4], e1[8 * kk + 5]), pack2(e1[8 * kk + 6], e1[8 * kk + 7])};
          }
        }
#pragma unroll
        for (int kk = 0; kk < 2; ++kk) {
          const bf16x8 p0 = __builtin_bit_cast(bf16x8, pk0[kk]);
          const bf16x8 p1 = __builtin_bit_cast(bf16x8, pk1[kk]);
#pragma unroll
          for (int vt = 0; vt < 2; ++vt) {
            const u16* vp = Vs + (vt * 32 + l31) * VST + sub * 32 + kk * 16 + 4 * hh;
            uint2 lo = *(const uint2*)vp, hi = *(const uint2*)(vp + 8);
            const bf16x8 vf = __builtin_bit_cast(bf16x8, uint4{lo.x, lo.y, hi.x, hi.y});
            o[vt][0] = __builtin_amdgcn_mfma_f32_32x32x16_bf16(vf, p0, o[vt][0], 0, 0, 0);
            o[vt][1] = __builtin_amdgcn_mfma_f32_32x32x16_bf16(vf, p1, o[vt][1], 0, 0, 0);
          }
        }
      }
    }
    if (more) {
      u16* kw = sm + ((kt + 1) & 1) * ABUF;
      *(uint4*)(kw + kso0) = kr0; *(uint4*)(kw + kso1) = kr1; *(uint4*)(kw + kso2) = kr2;
      *(uint4*)(kw + vso0) = vr0; *(uint4*)(kw + vso1) = vr1;
    }
    __syncthreads();
  }
  if (mylast >= 0) {
#pragma unroll
    for (int qt = 0; qt < 2; ++qt) {
      float l = lsum[qt] + __shfl_xor(lsum[qt], 32);
      const float inv = 1.f / l;
      const int tok = qtok0 + qt * 32 + l31;
#pragma unroll
      for (int vt = 0; vt < 2; ++vt)
#pragma unroll
        for (int g = 0; g < 4; ++g) {
          const int vd = vt * 32 + 8 * g + 4 * hh;
          uint2 w = {pack2(o[vt][qt][4 * g] * inv, o[vt][qt][4 * g + 1] * inv), pack2(o[vt][qt][4 * g + 2] * inv, o[vt][qt][4 * g + 3] * inv)};
          *(uint2*)(mix + (size_t)tok * 1024 + h * 64 + vd) = w;
        }
    }
  }
}

#ifndef MIX_SUB
#define MIX_SUB 3
#endif
DI void mixer_phase(const P& p, char* smem) {
  const int G = gridDim.x, b = blockIdx.x;
  if (MIX_SUB & 1) {
  for (int round = 0;; ++round) {
    int rank = round * G + ((round & 1) ? (G - 1 - b) : b);
    if (round * G >= 2048) break;
    if (rank < 2048) {
      int qb = 31 - (rank >> 6), bh = rank & 63;
      attn_item(p, bh >> 3, bh & 7, qb, smem);
    }
  }
  for (int it = G - 1 - b; it < 64; it += G) attn_item(p, 8 + (it >> 3), it & 7, 0, smem);
  }
  if (MIX_SUB & 2)
  for (int it = b; it < 4128; it += G) gla_passC(p, it, smem);
}

DI void fixup_phase(const P& p) {
  const float* first = (const float*)(p.ws + W_FIRST);
  const float* last = (const float*)(p.ws + W_LAST);
  u16* act = (u16*)(p.ws + W_ACT);
  for (int e = blockIdx.x * 256 + threadIdx.x; e < 1032 * 2816; e += gridDim.x * 256) {
    const int seg = e / 2816, ch = e - seg * 2816;
    float2 f0 = *(const float2*)(first + ((size_t)(seg * 2 + 0) * 2816 + ch) * 2);
    float2 f1 = *(const float2*)(first + ((size_t)(seg * 2 + 1) * 2816 + ch) * 2);
    float p0 = 0.f, p1 = 0.f;
    if (seg >= 1024) { p0 = p.state_conv[(size_t)((seg - 1024) * 2 + 0) * 2816 + ch]; p1 = p.state_conv[(size_t)((seg - 1024) * 2 + 1) * 2816 + ch]; }
    else if ((seg & 127) != 0) { p0 = last[(size_t)((seg - 1) * 2 + 0) * 2816 + ch]; p1 = last[(size_t)((seg - 1) * 2 + 1) * 2816 + ch]; }
    const float w0 = p.w_conv[ch], w1 = p.w_conv[2816 + ch], w2 = p.w_conv[5632 + ch], bb = p.b_conv[ch];
    float c0 = bb + w0 * p0 + w1 * p1 + w2 * f0.x;
    float c1 = bb + w0 * p1 + w1 * f0.x + w2 * f1.x;
    act[(size_t)(seg * 64) * 2816 + ch] = (u16)(pack2(gelu_tanh(c0) * f0.y, 0.f) & 0xffffu);
    act[(size_t)(seg * 64 + 1) * 2816 + ch] = (u16)(pack2(gelu_tanh(c1) * f1.y, 0.f) & 0xffffu);
  }
}

#ifndef ONLY_PH
#define ONLY_PH -1
#endif
#define PH_EN(n) (ONLY_PH < 0 || ONLY_PH == (n))
__global__ void __launch_bounds__(256, 2) mega(P p, int ph_lo, int ph_hi) {
  __shared__ __attribute__((aligned(16))) char smem[73728];
  cg::grid_group grid = cg::this_grid();
  const float* mods = (const float*)(p.ws + W_MODS);
  const float2* rope = (const float2*)(p.ws + W_ROPE);
#define PHASE(n, ...) if (PH_EN(n) && ph_lo <= (n) && (n) <= ph_hi) { __VA_ARGS__ } if (ph_lo <= (n) && (n) < ph_hi) grid.sync();
  PHASE(0, phase0(p, smem);)
  PHASE(1, prenorm_phase(p, false, p.g_norm1, 0, 1);)
  PHASE(2, { EpiProj e{(u16*)(p.ws + W_PROJ)};
             gemm_phase((const u16*)(p.ws + W_H), 1024, (const u16*)(p.ws + W_WIN), 1024, 516, 18, e, smem, 0); })
  PHASE(3, { rowlocal_phase(p);
             for (int it = blockIdx.x; it < 4128; it += gridDim.x) gla_passA(p, it, smem); })
  PHASE(4, { EpiQ e{(u16*)(p.ws + W_QF), p.g_qn, rope};
             gemm_phase((const u16*)(p.ws + W_QN), 384, (const u16*)(p.ws + W_WUQ), 384, 516, 8, e, smem, 0);
             EpiKV e2{(u16*)(p.ws + W_KF), (u16*)(p.ws + W_VTP), (u16*)(p.ws + W_VTS), (const float*)(p.ws + W_KPE), p.g_kn, rope};
             gemm_phase((const u16*)(p.ws + W_CKVB), 256, (const u16*)(p.ws + W_WUKV), 256, 580, 8, e2, smem, 4128);
             gla_passB(p); })
  PHASE(5, mixer_phase(p, smem);)
  PHASE(6, { EpiRes e{&p, nullptr, (float*)(p.ws + W_X1), mods, 2};
             gemm_phase((const u16*)(p.ws + W_H), 1024, (const u16*)(p.ws + W_WOUT), 1024, 516, 8, e, smem, 0); })
  PHASE(7, prenorm_phase(p, true, p.g_norm2, 3, 4);)
  PHASE(8, { EpiUp e{(u16*)(p.ws + W_ACT), (float*)(p.ws + W_FIRST), (float*)(p.ws + W_LAST), p.w_conv, p.b_conv, p.out};
             gemm_phase((const u16*)(p.ws + W_H), 1024, (const u16*)(p.ws + W_WUP), 1024, 516, 44, e, smem, 0); })
  PHASE(9, fixup_phase(p);)
  PHASE(10, { EpiRes e{&p, (const float*)(p.ws + W_X1), p.out + O_Y, mods, 5};
              gemm_phase((const u16*)(p.ws + W_ACT), 2816, (const u16*)(p.ws + W_WDN), 2816, 516, 8, e, smem, 0); })
}

extern "C" void kernel_launch(void* const* d_in, const int* in_sizes, int n_in, void* d_out, int out_size, void* d_ws,
                              size_t ws_size, hipStream_t stream) {
  static int grid_blocks = 0;
  if (!grid_blocks) {
    int dev = 0, cus = 0, per_cu = 0;
    hipGetDevice(&dev);
    hipDeviceGetAttribute(&cus, hipDeviceAttributeMultiprocessorCount, dev);
    hipOccupancyMaxActiveBlocksPerMultiprocessor(&per_cu, mega, 256, 0);
    if (per_cu < 1) per_cu = 1;
    if (per_cu > 2) per_cu = 2;
    grid_blocks = cus * per_cu;
  }
  P p{};
  const float** f = (const float**)&p;
  for (int i = 0; i < 27; ++i) f[i] = (const float*)d_in[i];
  p.out = (float*)d_out;
  p.ws = (char*)d_ws;
  int lo = 0, hi = 10;
  void* args[] = {&p, &lo, &hi};
  hipError_t e = hipLaunchCooperativeKernel((void*)mega, dim3(grid_blocks), dim3(256), args, 0, stream);
  if (e != hipSuccess) fprintf(stderr, "cooperative launch failed: %s (grid %d)\n", hipGetErrorString(e), grid_blocks);
}
```

```cpp
#include <hip/hip_runtime.h>
#include <hip/hip_cooperative_groups.h>
#include <cstdio>
namespace cg = cooperative_groups;

typedef unsigned short u16;
typedef unsigned int u32;
using bf16x8 = __attribute__((ext_vector_type(8))) short;
using f32x4 = __attribute__((ext_vector_type(4))) float;
using f32x16 = __attribute__((ext_vector_type(16))) float;
typedef __bf16 bf2_t __attribute__((ext_vector_type(2)));
typedef float fl2_t __attribute__((ext_vector_type(2)));
#define DI __device__ __forceinline__

constexpr int NTOK = 66048;
constexpr int NPTOK = 65536;
constexpr int G3ROWS = 74240;
constexpr int PROJ_LD = 2224;
constexpr int C_KV = 384, C_KPE = 640, C_GQ = 672, C_GK = 928, C_GV = 1184, C_LR = 1696, C_OG = 1712;
constexpr float EPS = 1e-6f;

constexpr size_t O_Y = 0;
constexpr size_t O_CKVP = 67108864 + 524288;
constexpr size_t O_KPEP = O_CKVP + 16777216;
constexpr size_t O_GLAP = O_KPEP + 2097152;
constexpr size_t O_CONVP = O_GLAP + 262144;
constexpr size_t O_CKVS = O_CONVP + 45056;
constexpr size_t O_KPES = O_CKVS + 131072;
constexpr size_t O_GLAS = O_KPES + 16384;
constexpr size_t O_CONVS = O_GLAS + 262144;

constexpr size_t al256(size_t x) { return (x + 255) & ~size_t(255); }
constexpr size_t W_MODS = 0;
constexpr size_t W_ROPE = W_MODS + al256(16 * 6144 * 4);
constexpr size_t W_WIN = W_ROPE + al256(8192 * 16 * 8);
constexpr size_t W_WUQ = W_WIN + al256((size_t)2304 * 1024 * 2);
constexpr size_t W_WUKV = W_WUQ + al256((size_t)1024 * 384 * 2);
constexpr size_t W_WOUT = W_WUKV + al256((size_t)1024 * 256 * 2);
constexpr size_t W_WUP = W_WOUT + al256((size_t)1024 * 1024 * 2);
constexpr size_t W_WDN = W_WUP + al256((size_t)5632 * 1024 * 2);
constexpr size_t W_KPE = W_WDN + al256((size_t)1024 * 2816 * 2);
constexpr size_t W_DBUF = W_KPE + al256((size_t)G3ROWS * 32 * 4);
constexpr size_t W_H = W_DBUF + al256((size_t)4096 * 64 * 4);
constexpr size_t W_RA = W_H + al256((size_t)NTOK * 1024 * 2);
constexpr size_t W_PROJ = W_RA;
constexpr size_t W_QN = W_PROJ + al256((size_t)NTOK * PROJ_LD * 2);
constexpr size_t W_CKVB = W_QN + al256((size_t)NTOK * 384 * 2);
constexpr size_t W_RA_END = W_CKVB + al256((size_t)G3ROWS * 256 * 2);
constexpr size_t W_ACT = W_RA;
constexpr size_t W_RB = W_RA_END;
constexpr size_t W_QF = W_RB;
constexpr size_t W_KF = W_QF + al256((size_t)NTOK * 768 * 2);
constexpr size_t W_VTP = W_KF + al256((size_t)8 * G3ROWS * 96 * 2);
constexpr size_t W_VTS = W_VTP + al256((size_t)64 * 64 * 8192 * 2);
constexpr size_t W_RB_END = W_VTS + al256((size_t)64 * 64 * 1088 * 2);
constexpr size_t W_X1 = W_RB;
constexpr size_t W_U = W_RB_END;
constexpr size_t W_FIRST = W_U;
constexpr size_t W_LAST = W_FIRST + al256((size_t)1032 * 2 * 2816 * 2 * 4);
constexpr size_t W_END = W_U + (size_t)4096 * 8192 * 4;
static_assert(W_ACT + (size_t)NTOK * 2816 * 2 <= W_RA_END, "act alias");
static_assert(W_X1 + (size_t)NTOK * 1024 * 4 <= W_RB_END, "x1 alias");
static_assert(W_LAST + (size_t)1032 * 2 * 2816 * 4 <= W_END, "first/last alias");
static_assert(W_END <= (size_t)1073741824, "workspace");

struct P {
  const float *x_prompt, *x_sample, *c_prompt, *c_sample, *cache_ckv, *cache_kpe, *state_gla, *state_conv;
  const float *w_ada, *b_ada, *g_norm1, *w_in, *g_qa, *w_uq, *g_qn, *g_kva, *w_ukv, *g_kn, *w_a2, *b_a2, *g_gla,
      *w_out, *g_norm2, *w_up, *w_conv, *b_conv, *w_down;
  float* out;
  char* ws;
};

DI u32 pack2(float a, float b) { fl2_t v = {a, b}; bf2_t r = __builtin_convertvector(v, bf2_t); return __builtin_bit_cast(u32, r); }
DI float bflo(u32 u) { return __uint_as_float(u << 16); }
DI float bfhi(u32 u) { return __uint_as_float(u & 0xffff0000u); }
DI float wave_sum(float v) {
#pragma unroll
  for (int o = 32; o > 0; o >>= 1) v += __shfl_xor(v, o);
  return v;
}
DI int tok_seq(int r) { return r < NPTOK ? (r >> 13) : 8 + ((r - NPTOK) >> 6); }
DI int tok_pos(int r) { return r < NPTOK ? (r & 8191) : 1024 + ((r - NPTOK) & 63); }
DI int tok_g3row(int r) { return r < NPTOK ? r : NPTOK + ((r - NPTOK) >> 6) * 1088 + 1024 + ((r - NPTOK) & 63); }
DI const float* x_row(const P& p, int r) { return r < NPTOK ? p.x_prompt + (size_t)r * 1024 : p.x_sample + (size_t)(r - NPTOK) * 1024; }
DI float silu_f(float x) { return x / (1.f + __expf(-x)); }
DI float gelu_tanh(float x) {
  float x2 = x * x;
  float w = x * (-2.302208198f - 0.1029432397f * x2);
  return x * __builtin_amdgcn_rcpf(1.f + __builtin_amdgcn_exp2f(w));
}
DI void unpack8(uint4 v, float* d) {
  d[0] = bflo(v.x); d[1] = bfhi(v.x); d[2] = bflo(v.y); d[3] = bfhi(v.y);
  d[4] = bflo(v.z); d[5] = bfhi(v.z); d[6] = bflo(v.w); d[7] = bfhi(v.w);
}

DI void ph0_mods(const P& p, int unit, float* sm) {
  const int t = threadIdx.x;
  for (int i = t; i < 16 * 1024; i += 512) {
    int s = i >> 10, k = i & 1023;
    float c = (s < 8) ? p.c_prompt[s * 1024 + k] : p.c_sample[(s - 8) * 1024 + k];
    sm[k * 16 + s] = c / (1.f + expf(-c));
  }
  __syncthreads();
  const int col = unit * 64 + (t & 63), kq = t >> 6;
  float acc[16];
#pragma unroll
  for (int s = 0; s < 16; ++s) acc[s] = 0.f;
  for (int k = kq * 128; k < kq * 128 + 128; ++k) {
    float w = p.w_ada[(size_t)k * 6144 + col];
    const float4* sp = (const float4*)(sm + k * 16);
    float4 a0 = sp[0], a1 = sp[1], a2 = sp[2], a3 = sp[3];
    acc[0] += a0.x * w; acc[1] += a0.y * w; acc[2] += a0.z * w; acc[3] += a0.w * w;
    acc[4] += a1.x * w; acc[5] += a1.y * w; acc[6] += a1.z * w; acc[7] += a1.w * w;
    acc[8] += a2.x * w; acc[9] += a2.y * w; acc[10] += a2.z * w; acc[11] += a2.w * w;
    acc[12] += a3.x * w; acc[13] += a3.y * w; acc[14] += a3.z * w; acc[15] += a3.w * w;
  }
  __syncthreads();
#pragma unroll
  for (int s = 0; s < 16; ++s) sm[(kq * 16 + s) * 64 + (t & 63)] = acc[s];
  __syncthreads();
  float* mods = (float*)(p.ws + W_MODS);
  for (int i = t; i < 16 * 64; i += 512) {
    int s = i >> 6, c = i & 63;
    float v = p.b_ada[unit * 64 + c];
#pragma unroll
    for (int q = 0; q < 8; ++q) v += sm[(q * 16 + s) * 64 + c];
    mods[s * 6144 + unit * 64 + c] = v;
  }
  __syncthreads();
}

DI void ph0_transpose(const float* __restrict__ W, int K, int N, u16* __restrict__ Wt, int mode, int kt, int nt, float* sm) {
  const int t = threadIdx.x;
  const int n0 = nt * 64, k0 = kt * 64;
  int src0, nvalid = 64;
  if (mode == 0) { src0 = n0; nvalid = N - n0; }
  else if (mode == 1) { int h = n0 >> 7, c = n0 & 127; src0 = h * 96 + c; nvalid = 96 - c; }
  else { int j = n0 >> 7, c = n0 & 127; src0 = (c < 64) ? j * 64 : 2816 + j * 64; }
  const int col = t & 63;
#pragma unroll
  for (int i = 0; i < 8; ++i) {
    int k = (t >> 6) + 8 * i;
    float v = (col < nvalid) ? W[(size_t)(k0 + k) * N + src0 + col] : 0.f;
    sm[k * 65 + col] = v;
  }
  __syncthreads();
  {
    int id = t, n = id >> 3, kc = id & 7;
    const float* s = sm + (kc * 8) * 65 + n;
    uint4 o;
    o.x = pack2(s[0], s[65]); o.y = pack2(s[130], s[195]); o.z = pack2(s[260], s[325]); o.w = pack2(s[390], s[455]);
    *(uint4*)(Wt + (size_t)(n0 + n) * K + k0 + kc * 8) = o;
  }
  __syncthreads();
}

DI void phase0(const P& p, char* smem) {
  float* sm = (float*)smem;
  const int t = threadIdx.x;
  constexpr int U_MODS = 96, U_WIN = 576, U_WUQ = 96, U_WUKV = 64, U_WOUT = 256, U_WUP = 1408, U_WDN = 704, U_CKV = 128, U_KPE = 16, U_ROPE = 8;
  constexpr int TOTAL = U_MODS + U_WIN + U_WUQ + U_WUKV + U_WOUT + U_WUP + U_WDN + U_CKV + U_KPE + U_ROPE;
  for (int u0 = blockIdx.x; u0 < TOTAL; u0 += gridDim.x) {
    int u = u0;
    if (u < U_MODS) { ph0_mods(p, u, sm); continue; }
    u -= U_MODS;
    if (u < U_WIN) { ph0_transpose(p.w_in, 1024, 2224, (u16*)(p.ws + W_WIN), 0, u / 36, u % 36, sm); continue; }
    u -= U_WIN;
    if (u < U_WUQ) { ph0_transpose(p.w_uq, 384, 768, (u16*)(p.ws + W_WUQ), 1, u / 16, u % 16, sm); continue; }
    u -= U_WUQ;
    if (u < U_WUKV) { ph0_transpose(p.w_ukv, 256, 1024, (u16*)(p.ws + W_WUKV), 0, u / 16, u % 16, sm); continue; }
    u -= U_WUKV;
    if (u < U_WOUT) { ph0_transpose(p.w_out, 1024, 1024, (u16*)(p.ws + W_WOUT), 0, u / 16, u % 16, sm); continue; }
    u -= U_WOUT;
    if (u < U_WUP) { ph0_transpose(p.w_up, 1024, 5632, (u16*)(p.ws + W_WUP), 2, u / 88, u % 88, sm); continue; }
    u -= U_WUP;
    if (u < U_WDN) { ph0_transpose(p.w_down, 2816, 1024, (u16*)(p.ws + W_WDN), 0, u / 16, u % 16, sm); continue; }
    u -= U_WDN;
    if (u < U_CKV) {
      u16* ckvb = (u16*)(p.ws + W_CKVB);
#pragma unroll
      for (int i = 0; i < 4; ++i) {
        int id = t + 512 * i;
        int row = u * 64 + (id >> 5), c8 = id & 31;
        int sb = row >> 10, pp = row & 1023;
        const float4* src = (const float4*)(p.cache_ckv + (size_t)row * 256 + c8 * 8);
        float4 a = src[0], b = src[1];
        uint4 o = {pack2(a.x, a.y), pack2(a.z, a.w), pack2(b.x, b.y), pack2(b.z, b.w)};
        *(uint4*)(ckvb + (size_t)(NPTOK + sb * 1088 + pp) * 256 + c8 * 8) = o;
      }
      continue;
    }
    u -= U_CKV;
    if (u < U_KPE) {
      float* kpa = (float*)(p.ws + W_KPE);
#pragma unroll
      for (int i = 0; i < 8; ++i) {
        int id = t + 512 * i;
        int row = u * 512 + (id >> 3), c4 = id & 7;
        int sb = row >> 10, pp = row & 1023;
        float4 v = *(const float4*)(p.cache_kpe + (size_t)row * 32 + c4 * 4);
        *(float4*)(kpa + (size_t)(NPTOK + sb * 1088 + pp) * 32 + c4 * 4) = v;
      }
      continue;
    }
    u -= U_KPE;
    {
      float2* rope = (float2*)(p.ws + W_ROPE);
      for (int i = 0; i < 32; ++i) {
        int e = u * 16384 + i * 512 + t;
        int pos = e >> 4, idx = e & 15;
        int q = idx >> 2, r = idx & 3;
        float base = (r == 0) ? 1.f : (r == 1) ? 0.5623413251903491f : (r == 2) ? 0.31622776601683794f : 0.1778279410038923f;
        float sc = (q == 0) ? 1.f : (q == 1) ? 0.1f : (q == 2) ? 0.01f : 0.001f;
        float inv = base * sc;
        float ang = (float)pos * inv;
        double rev = (double)ang * 0.15915494309189535;
        rev -= floor(rev);
        float fr = (float)rev;
        rope[e] = make_float2(__builtin_amdgcn_cosf(fr), __builtin_amdgcn_sinf(fr));
      }
    }
  }
}

DI void prenorm_phase(const P& p, bool from_x1, const float* __restrict__ g, int shift_idx, int scale_idx) {
  const int lane = threadIdx.x & 63, wave = threadIdx.x >> 6;
  const float* mods = (const float*)(p.ws + W_MODS);
  u16* hb = (u16*)(p.ws + W_H);
  const float* x1 = (const float*)(p.ws + W_X1);
  for (int r = blockIdx.x * 8 + wave; r < NTOK; r += gridDim.x * 8) {
    const float* xr = from_x1 ? x1 + (size_t)r * 1024 : x_row(p, r);
    const int s = tok_seq(r);
    float4 v[4];
    float ss = 0.f;
#pragma unroll
    for (int i = 0; i < 4; ++i) {
      v[i] = ((const float4*)xr)[lane + 64 * i];
      ss += v[i].x * v[i].x + v[i].y * v[i].y + v[i].z * v[i].z + v[i].w * v[i].w;
    }
    ss = wave_sum(ss);
    const float rstd = rsqrtf(ss * (1.f / 1024.f) + EPS);
#pragma unroll
    for (int i = 0; i < 4; ++i) {
      int col = (lane + 64 * i) * 4;
      float4 gg = *(const float4*)(g + col);
      float4 sc = *(const float4*)(mods + s * 6144 + scale_idx * 1024 + col);
      float4 sh = *(const float4*)(mods + s * 6144 + shift_idx * 1024 + col);
      float a = v[i].x * rstd * gg.x * (1.f + sc.x) + sh.x;
      float b = v[i].y * rstd * gg.y * (1.f + sc.y) + sh.y;
      float c = v[i].z * rstd * gg.z * (1.f + sc.z) + sh.z;
      float d = v[i].w * rstd * gg.w * (1.f + sc.w) + sh.w;
      uint2 o = {pack2(a, b), pack2(c, d)};
      *(uint2*)(hb + (size_t)r * 1024 + col) = o;
    }
  }
}

constexpr int LDSK = 72;
constexpr int CTS = 132;

template <int MODE = 0, class Epi>
DI void gemm_phase(const u16* __restrict__ A, int lda, const u16* __restrict__ Bt, int K, int mtiles, int ntiles, const Epi& epi,
                   char* smem, int rot) {
  constexpr int GLK = 64;
  u16* As = (u16*)smem;
  u16* Bs = As + 2 * 256 * GLK;
  const int t = threadIdx.x, lane = t & 63, wave = t >> 6, wr = wave >> 2, wc = wave & 3;
  const int fr = lane & 15, fq = lane >> 4;
  const int nk = K >> 6;
  const int total = mtiles * ntiles;
  const int G = gridDim.x;
  const int srow = t >> 3, skc = (t & 7) * 8;
  const int swc = ((t & 7) ^ ((srow >> 1) & 7)) * 8;
  const int fsw = (fr >> 1) & 7;
  const int ro0 = ((fq ^ fsw) * 8), ro1 = (((fq ^ fsw) ^ 4) * 8);
  const int bb = ((int)blockIdx.x - (rot % G) + G) % G;
  const bool swz = ((G & 7) == 0);
  const int chunk = G >> 3;
  for (int r = 0; r * G < total; ++r) {
    const int item = swz ? ((r * 8 + (bb & 7)) * chunk + (bb >> 3)) : (r * G + bb);
    if (item >= total) continue;
    const int band = item / (8 * ntiles), rem = item - band * 8 * ntiles;
    const int bhgt = min(8, mtiles - band * 8);
    const int nt = rem / bhgt, mt = band * 8 + (rem - nt * bhgt);
    const u16* Ag = A + (size_t)(mt * 256) * lda;
    const u16* Bg = Bt + (size_t)(nt * 256) * K;
    const int voa = srow * lda + swc, vob = srow * K + swc;
    f32x4 acc[8][4];
#pragma unroll
    for (int i = 0; i < 8; ++i)
#pragma unroll
      for (int j = 0; j < 4; ++j) acc[i][j] = f32x4{0.f, 0.f, 0.f, 0.f};
    char* const la = (char*)As + t * 16;
    char* const lb = (char*)Bs + t * 16;
#define GLDS16(gp, lp) __builtin_amdgcn_global_load_lds((const unsigned*)(gp), (unsigned*)(lp), 16, 0, 0)
#pragma unroll
    for (int i = 0; i < 4; ++i) {
      GLDS16(Ag + (size_t)(64 * i) * lda + voa, la + i * 8192);
      GLDS16(Bg + (size_t)(64 * i) * K + vob, lb + i * 8192);
    }
    __syncthreads();
    for (int kt = 0; kt < nk; ++kt) {
      const bool more = (MODE == 2) ? false : (kt + 1 < nk);
      if (more) {
        const u16* ag = Ag + (kt + 1) * 64;
        const u16* bg = Bg + (kt + 1) * 64;
        const int bo = ((kt + 1) & 1) * 32768;
#pragma unroll
        for (int i = 0; i < 4; ++i) {
          GLDS16(ag + (size_t)(64 * i) * lda + voa, la + bo + i * 8192);
          GLDS16(bg + (size_t)(64 * i) * K + vob, lb + bo + i * 8192);
        }
      }
      __builtin_amdgcn_sched_barrier(0);
      const u16* as = As + (kt & 1) * 256 * GLK + (wr * 128 + fr) * GLK;
      const u16* bs = Bs + (kt & 1) * 256 * GLK + (wc * 64 + fr) * GLK;
      bf16x8 bc[4], bn[4], ac[2], an[2];
#pragma unroll
      for (int j = 0; j < 4; ++j) bc[j] = *(const bf16x8*)(bs + j * 16 * GLK + ro0);
#pragma unroll
      for (int i = 0; i < 2; ++i) ac[i] = *(const bf16x8*)(as + i * 16 * GLK + ro0);
#pragma unroll
      for (int g = 0; g < 8; ++g) {
        const int ih = g & 3;
        if (g < 7) {
          const int gn = g + 1;
#pragma unroll
          for (int i = 0; i < 2; ++i) an[i] = *(const bf16x8*)(as + ((gn & 3) * 2 + i) * 16 * GLK + ((gn >> 2) ? ro1 : ro0));
        }
        if (g == 3) {
#pragma unroll
          for (int j = 0; j < 4; ++j) bn[j] = *(const bf16x8*)(bs + j * 16 * GLK + ro1);
        }
#pragma unroll
        for (int i = 0; i < 2; ++i)
#pragma unroll
          for (int j = 0; j < 4; ++j) acc[ih * 2 + i][j] = __builtin_amdgcn_mfma_f32_16x16x32_bf16(bc[j], ac[i], acc[ih * 2 + i][j], 0, 0, 0);
        __builtin_amdgcn_sched_barrier(0);
        ac[0] = an[0]; ac[1] = an[1];
        if (g == 3) {
#pragma unroll
          for (int j = 0; j < 4; ++j) bc[j] = bn[j];
        }
      }
      __syncthreads();
    }
    if (MODE != 0) {
      float sum = 0.f;
#pragma unroll
      for (int i = 0; i < 8; ++i)
#pragma unroll
        for (int j = 0; j < 4; ++j) sum += acc[i][j][0] + acc[i][j][1] + acc[i][j][2] + acc[i][j][3];
      if (sum == 123456.789f) ((float*)smem)[t] = sum;
      continue;
    }
#pragma unroll
    for (int bj = 0; bj < 2; ++bj) {
      if ((wc >> 1) == bj) {
        float* cw = (float*)smem + wr * (128 * CTS) + fr * CTS + (wc & 1) * 64 + fq * 4;
#pragma unroll
        for (int i = 0; i < 8; ++i)
#pragma unroll
          for (int j = 0; j < 4; ++j) *(f32x4*)(cw + i * 16 * CTS + j * 16) = acc[i][j];
      }
      __syncthreads();
      {
        int te = t;
        asm volatile("" : "+v"(te));
        const float* Ce = (const float*)smem + (te >> 8) * (128 * CTS);
        epi(mt * 2 + (te >> 8), nt * 2 + bj, Ce, te & 255);
      }
      __syncthreads();
    }
  }
}

struct EpiProj {
  u16* proj;
  DI void operator()(int mt, int nt, const float* Ct, const int t) const {
#pragma unroll 2
    for (int i = 0; i < 8; ++i) {
      int id = t + 256 * i, row = id >> 4, c8 = id & 15;
      int col = nt * 128 + c8 * 8;
      if (col < PROJ_LD) {
        const float* c = Ct + row * CTS + c8 * 8;
        float4 a = *(const float4*)c, b = *(const float4*)(c + 4);
        uint4 o = {pack2(a.x, a.y), pack2(a.z, a.w), pack2(b.x, b.y), pack2(b.z, b.w)};
        *(uint4*)(proj + (size_t)(mt * 128 + row) * PROJ_LD + col) = o;
      }
    }
  }
};

struct EpiQ {
  u16* Qf; const float* g_qn; const float2* rope;
  DI void operator()(int mt, int nt, const float* Ct, const int t) const {
    const int row = t >> 1, half = t & 1;
    const int r = mt * 128 + row;
    const float QS = 0.14724445f;
    const float* c = Ct + row * CTS + half * 48;
    float ss = 0.f;
#pragma unroll 4
    for (int i = 0; i < 12; ++i) {
      float4 x = *(const float4*)(c + 4 * i);
      ss += x.x * x.x + x.y * x.y + x.z * x.z + x.w * x.w;
    }
    ss += __shfl_xor(ss, 1);
    const float rs = rsqrtf(ss * (1.f / 96.f) + EPS) * QS;
    u16* dst = Qf + ((size_t)r * 8 + nt) * 96 + half * 48;
    const float* g = g_qn + half * 48;
    const int nplain = half ? 2 : 6;
#pragma unroll 1
    for (int i = 0; i < nplain; ++i) {
      float4 x0 = *(const float4*)(c + 8 * i), x1 = *(const float4*)(c + 8 * i + 4);
      float4 g0 = *(const float4*)(g + 8 * i), g1 = *(const float4*)(g + 8 * i + 4);
      uint4 o = {pack2(x0.x * rs * g0.x, x0.y * rs * g0.y), pack2(x0.z * rs * g0.z, x0.w * rs * g0.w),
                 pack2(x1.x * rs * g1.x, x1.y * rs * g1.y), pack2(x1.z * rs * g1.z, x1.w * rs * g1.w)};
      *(uint4*)(dst + 8 * i) = o;
    }
    if (half) {
      const int pos = tok_pos(r);
#pragma unroll 1
      for (int mg = 0; mg < 4; ++mg) {
        float o1[4], o2[4];
#pragma unroll
        for (int m = 0; m < 4; ++m) {
          const int mm = mg * 4 + m;
          float n1 = c[16 + mm] * rs * g_qn[64 + mm], n2 = c[32 + mm] * rs * g_qn[80 + mm];
          float2 cs = rope[pos * 16 + mm];
          o1[m] = n1 * cs.x - n2 * cs.y;
          o2[m] = n2 * cs.x + n1 * cs.y;
        }
        *(uint2*)(dst + 16 + mg * 4) = uint2{pack2(o1[0], o1[1]), pack2(o1[2], o1[3])};
        *(uint2*)(dst + 32 + mg * 4) = uint2{pack2(o2[0], o2[1]), pack2(o2[2], o2[3])};
      }
    }
  }
};

struct EpiKV {
  u16* Kf; u16* VtP; u16* VtS; const float* kpe_all; const float* g_kn; const float2* rope;
  DI void operator()(int mt, int nt, const float* Ct, const int t) const {
    const int row = t >> 1, half = t & 1;
    const int r = mt * 128 + row;
    int seq, pos;
    if (r < NPTOK) { seq = r >> 13; pos = r & 8191; } else { int rr = r - NPTOK; seq = 8 + rr / 1088; pos = rr - (seq - 8) * 1088; }
    u16* dst = Kf + ((size_t)nt * G3ROWS + r) * 96;
    const float* c = Ct + row * CTS;
    const float* kp = kpe_all + (size_t)r * 32;
    float ss = 0.f;
    if (half == 0) {
#pragma unroll 4
      for (int i = 0; i < 16; ++i) {
        float4 x = *(const float4*)(c + 4 * i);
        ss += x.x * x.x + x.y * x.y + x.z * x.z + x.w * x.w;
      }
    } else {
#pragma unroll 4
      for (int i = 0; i < 8; ++i) {
        float4 x = *(const float4*)(kp + 4 * i);
        ss += x.x * x.x + x.y * x.y + x.z * x.z + x.w * x.w;
      }
    }
    ss += __shfl_xor(ss, 1);
    const float rs = rsqrtf(ss * (1.f / 96.f) + EPS);
    if (half == 0) {
#pragma unroll 1
      for (int i = 0; i < 8; ++i) {
        float4 x0 = *(const float4*)(c + 8 * i), x1 = *(const float4*)(c + 8 * i + 4);
        float4 g0 = *(const float4*)(g_kn + 8 * i), g1 = *(const float4*)(g_kn + 8 * i + 4);
        uint4 o = {pack2(x0.x * rs * g0.x, x0.y * rs * g0.y), pack2(x0.z * rs * g0.z, x0.w * rs * g0.w),
                   pack2(x1.x * rs * g1.x, x1.y * rs * g1.y), pack2(x1.z * rs * g1.z, x1.w * rs * g1.w)};
        *(uint4*)(dst + 8 * i) = o;
      }
    } else {
#pragma unroll 1
      for (int mg = 0; mg < 4; ++mg) {
        float o1[4], o2[4];
#pragma unroll
        for (int m = 0; m < 4; ++m) {
          const int mm = mg * 4 + m;
          float n1 = kp[mm] * rs * g_kn[64 + mm], n2 = kp[16 + mm] * rs * g_kn[80 + mm];
          float2 cs = rope[pos * 16 + mm];
          o1[m] = n1 * cs.x - n2 * cs.y;
          o2[m] = n2 * cs.x + n1 * cs.y;
        }
        *(uint2*)(dst + 64 + mg * 4) = uint2{pack2(o1[0], o1[1]), pack2(o1[2], o1[3])};
        *(uint2*)(dst + 80 + mg * 4) = uint2{pack2(o2[0], o2[1]), pack2(o2[2], o2[3])};
      }
    }
#pragma unroll 1
    for (int i = 0; i < 4; ++i) {
      int id = t + 256 * i, rg = id & 15, vd = id >> 4;
      int r0 = mt * 128 + rg * 8;
      const float* c = Ct + (rg * 8) * CTS + 64 + vd;
      uint4 o = {pack2(c[0], c[CTS]), pack2(c[2 * CTS], c[3 * CTS]), pack2(c[4 * CTS], c[5 * CTS]), pack2(c[6 * CTS], c[7 * CTS])};
      u16* d;
      if (r0 < NPTOK) { int sq = r0 >> 13, p0 = r0 & 8191; d = VtP + ((size_t)((sq * 8 + nt) * 64 + vd)) * 8192 + p0; }
      else { int rr = r0 - NPTOK; int sb = rr / 1088; int p0 = rr - sb * 1088; d = VtS + ((size_t)((sb * 8 + nt) * 64 + vd)) * 1088 + p0; }
      *(uint4*)d = o;
    }
  }
};

struct EpiRes {
  const P* pp; const float* src_x1; float* dst; const float* mods; int gate_idx;
  DI void operator()(int mt, int nt, const float* Ct, const int t) const {
#pragma unroll 4
    for (int i = 0; i < 16; ++i) {
      int id = t + 256 * i, row = id >> 5, c4 = id & 31;
      int r = mt * 128 + row, col = nt * 128 + c4 * 4;
      int s = tok_seq(r);
      float4 a = *(const float4*)(Ct + row * CTS + c4 * 4);
      const float* sr = src_x1 ? src_x1 + (size_t)r * 1024 : x_row(*pp, r);
      float4 xv = *(const float4*)(sr + col);
      float4 g = *(const float4*)(mods + s * 6144 + gate_idx * 1024 + col);
      float4 o = {xv.x + g.x * a.x, xv.y + g.y * a.y, xv.z + g.z * a.z, xv.w + g.w * a.w};
      *(float4*)(dst + (size_t)r * 1024 + col) = o;
    }
  }
};

struct EpiUp {
  u16* act; float* first; float* last; const float* w_conv; const float* b_conv; float* out;
  DI void operator()(int mt, int nt, const float* Ct, const int t) const {
    const int cp = t & 31, rgp = t >> 5;
    const int ch = nt * 64 + 2 * cp;
    const float2 w0 = *(const float2*)(w_conv + ch), w1 = *(const float2*)(w_conv + 2816 + ch), w2 = *(const float2*)(w_conv + 5632 + ch);
    const float2 bb = *(const float2*)(b_conv + ch);
    const int rbase = rgp * 16;
    float2 am2 = {0.f, 0.f}, am1 = {0.f, 0.f};
    if ((rbase & 63) != 0) {
      am2 = *(const float2*)(Ct + (rbase - 2) * CTS + 2 * cp);
      am1 = *(const float2*)(Ct + (rbase - 1) * CTS + 2 * cp);
    }
#pragma unroll 1
    for (int rr = 0; rr < 16; ++rr) {
      const int row = rbase + rr;
      const float2 a = *(const float2*)(Ct + row * CTS + 2 * cp);
      const float2 g = *(const float2*)(Ct + row * CTS + 64 + 2 * cp);
      const int r = mt * 128 + row, sr = row & 63, seg = r >> 6;
      if (sr >= 2) {
        float c0 = bb.x + w0.x * am2.x + w1.x * am1.x + w2.x * a.x;
        float c1 = bb.y + w0.y * am2.y + w1.y * am1.y + w2.y * a.y;
        *(u32*)(act + (size_t)r * 2816 + ch) = pack2(gelu_tanh(c0) * g.x, gelu_tanh(c1) * g.y);
      } else {
        float4 o = {a.x, g.x, a.y, g.y};
        *(float4*)(first + ((size_t)(seg * 2 + sr) * 2816 + ch) * 2) = o;
      }
      if (sr >= 62) {
        *(float2*)(last + (size_t)(seg * 2 + (sr - 62)) * 2816 + ch) = a;
        if (seg >= 1024) *(float2*)(out + O_CONVS + (size_t)((seg - 1024) * 2 + (sr - 62)) * 2816 + ch) = a;
        else if ((seg & 127) == 127) *(float2*)(out + O_CONVP + (size_t)((seg >> 7) * 2 + (sr - 62)) * 2816 + ch) = a;
      }
      am2 = am1; am1 = a;
    }
  }
};

DI void rowlocal_phase(const P& p) {
  const int lane = threadIdx.x & 63, wave = threadIdx.x >> 6;
  const u16* proj = (const u16*)(p.ws + W_PROJ);
  u16* qn = (u16*)(p.ws + W_QN);
  u16* ckvb = (u16*)(p.ws + W_CKVB);
  float* kpa = (float*)(p.ws + W_KPE);
  for (int r = blockIdx.x * 8 + wave; r < NTOK; r += gridDim.x * 8) {
    const u16* pr = proj + (size_t)r * PROJ_LD;
    const u32* pq = (const u32*)(pr + lane * 6);
    u32 q0 = pq[0], q1 = pq[1], q2 = pq[2];
    uint2 kv = *(const uint2*)(pr + C_KV + lane * 4);
    float qv[6] = {bflo(q0), bfhi(q0), bflo(q1), bfhi(q1), bflo(q2), bfhi(q2)};
    float kk[4] = {bflo(kv.x), bfhi(kv.x), bflo(kv.y), bfhi(kv.y)};
    float sq = 0.f, sk = 0.f;
#pragma unroll
    for (int i = 0; i < 6; ++i) sq += qv[i] * qv[i];
#pragma unroll
    for (int i = 0; i < 4; ++i) sk += kk[i] * kk[i];
    sq = wave_sum(sq); sk = wave_sum(sk);
    const float rq = rsqrtf(sq * (1.f / 384.f) + EPS), rk = rsqrtf(sk * (1.f / 256.f) + EPS);
    u32* dq = (u32*)(qn + (size_t)r * 384 + lane * 6);
    const float* gq = p.g_qa + lane * 6;
    dq[0] = pack2(qv[0] * rq * gq[0], qv[1] * rq * gq[1]);
    dq[1] = pack2(qv[2] * rq * gq[2], qv[3] * rq * gq[3]);
    dq[2] = pack2(qv[4] * rq * gq[4], qv[5] * rq * gq[5]);
    float4 gk = *(const float4*)(p.g_kva + lane * 4);
    float4 cv = {kk[0] * rk * gk.x, kk[1] * rk * gk.y, kk[2] * rk * gk.z, kk[3] * rk * gk.w};
    float* co = (r < NPTOK) ? p.out + O_CKVP + (size_t)r * 256 : p.out + O_CKVS + (size_t)(r - NPTOK) * 256;
    *(float4*)(co + lane * 4) = cv;
    const int g3 = tok_g3row(r);
    uint2 cb = {pack2(cv.x, cv.y), pack2(cv.z, cv.w)};
    *(uint2*)(ckvb + (size_t)g3 * 256 + lane * 4) = cb;
    if (lane < 32) {
      float kp = __uint_as_float(((u32)pr[C_KPE + lane]) << 16);
      float* ko = (r < NPTOK) ? p.out + O_KPEP + (size_t)r * 32 : p.out + O_KPES + (size_t)(r - NPTOK) * 32;
      ko[lane] = kp;
      kpa[(size_t)g3 * 32 + lane] = kp;
    }
  }
}

constexpr int GS = 68;
DI void gla_prep(const P& p, const u16* proj, int r0, int h, float* sV, float* sS) {
  const int t = threadIdx.x & 255;
  if (t < 128) {
    int row = t >> 1, hf = t & 1;
    uint4 v = *(const uint4*)(proj + (size_t)(r0 + row) * PROJ_LD + C_LR + hf * 8);
    unpack8(v, sV + row * 16 + hf * 8);
  }
#pragma unroll
  for (int i = 0; i < 4; ++i) {
    int id = t + 256 * i, rr = id >> 6, d = id & 63;
    sV[1024 + id] = p.w_a2[rr * 256 + h * 64 + d];
  }
  __syncthreads();
  {
    const int d = t & 63, tg = t >> 6;
    float wv[16];
#pragma unroll
    for (int rr = 0; rr < 16; ++rr) wv[rr] = sV[1024 + rr * 64 + d];
    const float bb = p.b_a2[h * 64 + d];
    for (int tt = 0; tt < 16; ++tt) {
      const int tk = tg * 16 + tt;
      const float4* gp = (const float4*)(sV + tk * 16);
      float4 g0 = gp[0], g1 = gp[1], g2 = gp[2], g3 = gp[3];
      float z = bb + g0.x * wv[0] + g0.y * wv[1] + g0.z * wv[2] + g0.w * wv[3] + g1.x * wv[4] + g1.y * wv[5] + g1.z * wv[6] + g1.w * wv[7] +
                g2.x * wv[8] + g2.y * wv[9] + g2.z * wv[10] + g2.w * wv[11] + g3.x * wv[12] + g3.y * wv[13] + g3.z * wv[14] + g3.w * wv[15];
      float ls = fminf(z, 0.f) - log1pf(expf(-fabsf(z)));
      sS[tk * GS + d] = ls * (1.f / 16.f);
    }
  }
  __syncthreads();
  if (t < 64) {
    float run = 0.f;
    for (int tk = 0; tk < 64; ++tk) { run += sS[tk * GS + t]; sS[tk * GS + t] = run; }
  }
  __syncthreads();
}

DI void gla_passA(const P& p, int item, char* smem) {
  float* sm = (float*)smem;
  float* sQV = sm;
  float* sV = sm + 4352;
  float* sK = sm + 8704;
  float* sS = sm + 13056;
  const u16* proj = (const u16*)(p.ws + W_PROJ);
  const int t = threadIdx.x & 255;
  int r0, h;
  if (item < 4096) { int ch = item >> 7, c = item & 127; h = ch & 3; r0 = (ch >> 2) * 8192 + c * 64; }
  else { int j = item - 4096; h = j & 3; r0 = NPTOK + (j >> 2) * 64; }
  gla_prep(p, proj, r0, h, sV, sS);
#pragma unroll
  for (int i = 0; i < 8; ++i) {
    int id = t + 256 * i, row = id >> 5, dp = id & 31;
    u32 kk = *(const u32*)(proj + (size_t)(r0 + row) * PROJ_LD + C_GK + h * 64 + dp * 2);
    float bl0 = sS[63 * GS + 2 * dp], bl1 = sS[63 * GS + 2 * dp + 1];
    sK[row * GS + 2 * dp] = bflo(kk) * expf(bl0 - sS[row * GS + 2 * dp]);
    sK[row * GS + 2 * dp + 1] = bfhi(kk) * expf(bl1 - sS[row * GS + 2 * dp + 1]);
  }
  __syncthreads();
#pragma unroll
  for (int i = 0; i < 4; ++i) {
    int id = t + 256 * i, row = id >> 4, ec = id & 15;
    uint4 v = *(const uint4*)(proj + (size_t)(r0 + row) * PROJ_LD + C_GV + h * 128 + ec * 8);
    float f[8];
    unpack8(v, f);
    *(float4*)(sQV + row * 132 + ec * 8) = make_float4(f[0], f[1], f[2], f[3]);
    *(float4*)(sQV + row * 132 + ec * 8 + 4) = make_float4(f[4], f[5], f[6], f[7]);
  }
  __syncthreads();
  const int td = t >> 4, te = t & 15;
  float U[4][8];
#pragma unroll
  for (int a = 0; a < 4; ++a)
#pragma unroll
    for (int b = 0; b < 8; ++b) U[a][b] = 0.f;
#pragma unroll 2
  for (int j = 0; j < 64; ++j) {
    float4 kv = *(const float4*)(sK + j * GS + 4 * td);
    float4 v0 = *(const float4*)(sQV + j * 132 + 4 * te);
    float4 v1 = *(const float4*)(sQV + j * 132 + 64 + 4 * te);
    float kx[4] = {kv.x, kv.y, kv.z, kv.w};
#pragma unroll
    for (int a = 0; a < 4; ++a) {
      U[a][0] += kx[a] * v0.x; U[a][1] += kx[a] * v0.y; U[a][2] += kx[a] * v0.z; U[a][3] += kx[a] * v0.w;
      U[a][4] += kx[a] * v1.x; U[a][5] += kx[a] * v1.y; U[a][6] += kx[a] * v1.z; U[a][7] += kx[a] * v1.w;
    }
  }
  if (item < 4096) {
    float* Ub = (float*)(p.ws + W_U) + (size_t)item * 8192;
    float* db = (float*)(p.ws + W_DBUF) + (size_t)item * 64;
#pragma unroll
    for (int a = 0; a < 4; ++a) {
      int d = 4 * td + a;
      *(float4*)(Ub + d * 128 + 4 * te) = make_float4(U[a][0], U[a][1], U[a][2], U[a][3]);
      *(float4*)(Ub + d * 128 + 64 + 4 * te) = make_float4(U[a][4], U[a][5], U[a][6], U[a][7]);
      if (te == 0) db[d] = expf(sS[63 * GS + d]);
    }
  } else {
    const int j = item - 4096;
    const float* S0 = p.state_gla + (size_t)j * 8192;
    float* So = p.out + O_GLAS + (size_t)j * 8192;
#pragma unroll
    for (int a = 0; a < 4; ++a) {
      int d = 4 * td + a;
      float dec = expf(sS[63 * GS + d]);
      float4 s0 = *(const float4*)(S0 + d * 128 + 4 * te), s1 = *(const float4*)(S0 + d * 128 + 64 + 4 * te);
      *(float4*)(So + d * 128 + 4 * te) = make_float4(dec * s0.x + U[a][0], dec * s0.y + U[a][1], dec * s0.z + U[a][2], dec * s0.w + U[a][3]);
      *(float4*)(So + d * 128 + 64 + 4 * te) = make_float4(dec * s1.x + U[a][4], dec * s1.y + U[a][5], dec * s1.z + U[a][6], dec * s1.w + U[a][7]);
    }
  }
  __syncthreads();
}

DI void gla_passB(const P& p) {
  float* Ub = (float*)(p.ws + W_U);
  const float* db = (const float*)(p.ws + W_DBUF);
  for (int e = blockIdx.x * 512 + threadIdx.x; e < 32 * 8192; e += gridDim.x * 512) {
    const int chain = e >> 13, de = e & 8191, d = de >> 7;
    float S = 0.f;
    float* ub = Ub + (size_t)chain * 128 * 8192 + de;
    const float* dd = db + (size_t)chain * 128 * 64 + d;
#pragma unroll 8
    for (int c = 0; c < 128; ++c) {
      float u = ub[(size_t)c * 8192];
      float dec = dd[c * 64];
      ub[(size_t)c * 8192] = S;
      S = dec * S + u;
    }
    p.out[O_GLAP + e] = S;
  }
}

DI void gla_passC(const P& p, int item, char* smem) {
  float* sm = (float*)smem;
  float* sQ = sm;
  float* sV = sm + 4352;
  float* sK = sm + 8704;
  float* sS = sm + 13056;
  const u16* proj = (const u16*)(p.ws + W_PROJ);
  u16* mix = (u16*)(p.ws + W_H);
  const int t = threadIdx.x & 255;
  int r0, h;
  const float* Ssrc;
  if (item < 4096) { int ch = item >> 7, c = item & 127; h = ch & 3; r0 = (ch >> 2) * 8192 + c * 64; Ssrc = (const float*)(p.ws + W_U) + (size_t)item * 8192; }
  else { int j = item - 4096; h = j & 3; r0 = NPTOK + (j >> 2) * 64; Ssrc = p.state_gla + (size_t)j * 8192; }
  gla_prep(p, proj, r0, h, sV, sS);
#pragma unroll
  for (int i = 0; i < 8; ++i) {
    int id = t + 256 * i, row = id >> 5, dp = id & 31;
    u32 qq = *(const u32*)(proj + (size_t)(r0 + row) * PROJ_LD + C_GQ + h * 64 + dp * 2);
    u32 kk = *(const u32*)(proj + (size_t)(r0 + row) * PROJ_LD + C_GK + h * 64 + dp * 2);
    float b0 = sS[row * GS + 2 * dp], b1 = sS[row * GS + 2 * dp + 1];
    sQ[row * GS + 2 * dp] = bflo(qq) * 0.125f * expf(b0);
    sQ[row * GS + 2 * dp + 1] = bfhi(qq) * 0.125f * expf(b1);
    sK[row * GS + 2 * dp] = bflo(kk) * expf(-b0);
    sK[row * GS + 2 * dp + 1] = bfhi(kk) * expf(-b1);
  }
  __syncthreads();
  const int ti = t >> 4, tj = t & 15;
  float A[4][4];
#pragma unroll
  for (int a = 0; a < 4; ++a)
#pragma unroll
    for (int b = 0; b < 4; ++b) A[a][b] = 0.f;
#pragma unroll 1
  for (int d4 = 0; d4 < 16; ++d4) {
    float4 q[4], k[4];
#pragma unroll
    for (int a = 0; a < 4; ++a) q[a] = *(const float4*)(sQ + (ti + 16 * a) * GS + 4 * d4);
#pragma unroll
    for (int b = 0; b < 4; ++b) k[b] = *(const float4*)(sK + (tj + 16 * b) * GS + 4 * d4);
#pragma unroll
    for (int a = 0; a < 4; ++a)
#pragma unroll
      for (int b = 0; b < 4; ++b) A[a][b] += q[a].x * k[b].x + q[a].y * k[b].y + q[a].z * k[b].z + q[a].w * k[b].w;
  }
  __syncthreads();
#pragma unroll
  for (int a = 0; a < 4; ++a)
#pragma unroll
    for (int b = 0; b < 4; ++b) sK[(ti + 16 * a) * GS + tj + 16 * b] = ((tj + 16 * b) <= (ti + 16 * a)) ? A[a][b] : 0.f;
  float o[2][4][4];
#pragma unroll
  for (int hf = 0; hf < 2; ++hf) {
#pragma unroll
    for (int i = 0; i < 2; ++i) {
      int id = t + 256 * i, row = id >> 3, ec = id & 7;
      uint4 v = *(const uint4*)(proj + (size_t)(r0 + row) * PROJ_LD + C_GV + h * 128 + hf * 64 + ec * 8);
      float f[8];
      unpack8(v, f);
      *(float4*)(sV + row * GS + ec * 8) = make_float4(f[0], f[1], f[2], f[3]);
      *(float4*)(sV + row * GS + ec * 8 + 4) = make_float4(f[4], f[5], f[6], f[7]);
    }
#pragma unroll
    for (int i = 0; i < 4; ++i) {
      int id = t + 256 * i, d = id >> 4, e4 = id & 15;
      *(float4*)(sS + d * GS + e4 * 4) = *(const float4*)(Ssrc + d * 128 + hf * 64 + e4 * 4);
    }
    __syncthreads();
#pragma unroll
    for (int a = 0; a < 4; ++a)
#pragma unroll
      for (int c = 0; c < 4; ++c) o[hf][a][c] = 0.f;
#pragma unroll 1
    for (int j4 = 0; j4 < 16; ++j4) {
      float4 av[4], vv[4];
#pragma unroll
      for (int a = 0; a < 4; ++a) av[a] = *(const float4*)(sK + (ti + 16 * a) * GS + 4 * j4);
#pragma unroll
      for (int b = 0; b < 4; ++b) vv[b] = *(const float4*)(sV + (4 * j4 + b) * GS + 4 * tj);
#pragma unroll
      for (int a = 0; a < 4; ++a) {
        o[hf][a][0] += av[a].x * vv[0].x + av[a].y * vv[1].x + av[a].z * vv[2].x + av[a].w * vv[3].x;
        o[hf][a][1] += av[a].x * vv[0].y + av[a].y * vv[1].y + av[a].z * vv[2].y + av[a].w * vv[3].y;
        o[hf][a][2] += av[a].x * vv[0].z + av[a].y * vv[1].z + av[a].z * vv[2].z + av[a].w * vv[3].z;
        o[hf][a][3] += av[a].x * vv[0].w + av[a].y * vv[1].w + av[a].z * vv[2].w + av[a].w * vv[3].w;
      }
    }
#pragma unroll 1
    for (int d4 = 0; d4 < 16; ++d4) {
      float4 av[4], vv[4];
#pragma unroll
      for (int a = 0; a < 4; ++a) av[a] = *(const float4*)(sQ + (ti + 16 * a) * GS + 4 * d4);
#pragma unroll
      for (int b = 0; b < 4; ++b) vv[b] = *(const float4*)(sS + (4 * d4 + b) * GS + 4 * tj);
#pragma unroll
      for (int a = 0; a < 4; ++a) {
        o[hf][a][0] += av[a].x * vv[0].x + av[a].y * vv[1].x + av[a].z * vv[2].x + av[a].w * vv[3].x;
        o[hf][a][1] += av[a].x * vv[0].y + av[a].y * vv[1].y + av[a].z * vv[2].y + av[a].w * vv[3].y;
        o[hf][a][2] += av[a].x * vv[0].z + av[a].y * vv[1].z + av[a].z * vv[2].z + av[a].w * vv[3].z;
        o[hf][a][3] += av[a].x * vv[0].w + av[a].y * vv[1].w + av[a].z * vv[2].w + av[a].w * vv[3].w;
      }
    }
    __syncthreads();
  }
#pragma unroll
  for (int a = 0; a < 4; ++a) {
    float ss = 0.f;
#pragma unroll
    for (int hf = 0; hf < 2; ++hf)
#pragma unroll
      for (int c = 0; c < 4; ++c) ss += o[hf][a][c] * o[hf][a][c];
    ss += __shfl_xor(ss, 1); ss += __shfl_xor(ss, 2); ss += __shfl_xor(ss, 4); ss += __shfl_xor(ss, 8);
    const float rs = rsqrtf(ss * (1.f / 128.f) + EPS);
    const int r = r0 + ti + 16 * a;
#pragma unroll
    for (int hf = 0; hf < 2; ++hf) {
      const int e = hf * 64 + 4 * tj;
      uint2 og = *(const uint2*)(proj + (size_t)r * PROJ_LD + C_OG + h * 128 + e);
      float4 gg = *(const float4*)(p.g_gla + e);
      float v0 = o[hf][a][0] * rs * gg.x * silu_f(bflo(og.x));
      float v1 = o[hf][a][1] * rs * gg.y * silu_f(bfhi(og.x));
      float v2 = o[hf][a][2] * rs * gg.z * silu_f(bflo(og.y));
      float v3 = o[hf][a][3] * rs * gg.w * silu_f(bfhi(og.y));
      uint2 w = {pack2(v0, v1), pack2(v2, v3)};
      *(uint2*)(mix + (size_t)r * 1024 + 512 + h * 128 + e) = w;
    }
  }
  __syncthreads();
}

constexpr int KST = 104, VST = 68, ABUF = 64 * KST + 64 * VST;
DI void attn_item(const P& p, int seq, int h, int qb, char* smem) {
  const u16* Qf = (const u16*)(p.ws + W_QF);
  const u16* Kf = (const u16*)(p.ws + W_KF);
  u16* mix = (u16*)(p.ws + W_H);
  u16* sm = (u16*)smem;
  const int t = threadIdx.x, lane = t & 63, wave = t >> 6, l31 = lane & 31, hh = lane >> 5;
  int ntiles, mylast, qtok0, Lk;
  const u16 *Kb, *Vb;
  if (seq < 8) {
    ntiles = qb * 8 + 8; mylast = qb * 8 + wave; qtok0 = seq * 8192 + qb * 512 + wave * 64; Lk = 8192;
    Kb = Kf + ((size_t)h * G3ROWS + seq * 8192) * 96;
    Vb = (const u16*)(p.ws + W_VTP) + (size_t)((seq * 8 + h) * 64) * 8192;
  } else {
    ntiles = 17; mylast = (wave == 0) ? 16 : -1; qtok0 = NPTOK + (seq - 8) * 64; Lk = 1088;
    Kb = Kf + ((size_t)h * G3ROWS + NPTOK + (seq - 8) * 1088) * 96;
    Vb = (const u16*)(p.ws + W_VTS) + (size_t)(((seq - 8) * 8 + h) * 64) * 1088;
  }
  bf16x8 qf[2][6];
#pragma unroll
  for (int qt = 0; qt < 2; ++qt)
#pragma unroll
    for (int ks = 0; ks < 6; ++ks) {
      if (mylast >= 0) qf[qt][ks] = *(const bf16x8*)(Qf + ((size_t)(qtok0 + qt * 32 + l31) * 8 + h) * 96 + ks * 16 + hh * 8);
      else qf[qt][ks] = bf16x8{0, 0, 0, 0, 0, 0, 0, 0};
    }
  f32x16 o[2][2];
#pragma unroll
  for (int a = 0; a < 2; ++a)
#pragma unroll
    for (int b = 0; b < 2; ++b)
#pragma unroll
      for (int e = 0; e < 16; ++e) o[a][b][e] = 0.f;
  float lsum[2] = {0.f, 0.f};
  const bool k2 = (t < 256);
  const int kid0 = t, kid1 = k2 ? t + 512 : t;
  const int krow0 = kid0 / 12, krow1 = kid1 / 12;
  const int kso0 = krow0 * KST + (kid0 - krow0 * 12) * 8, kso1 = krow1 * KST + (kid1 - krow1 * 12) * 8;
  const int vd0 = t >> 3, vch = t & 7;
  const int vso0 = 64 * KST + vd0 * VST + vch * 8;
  const u16* vg0 = Vb + (size_t)vd0 * Lk + vch * 8;
  uint4 kr0, kr1, vr0;
  kr0 = *(const uint4*)(Kb + (size_t)kid0 * 8); kr1 = *(const uint4*)(Kb + (size_t)kid1 * 8);
  vr0 = *(const uint4*)vg0;
  *(uint4*)(sm + kso0) = kr0; if (k2) *(uint4*)(sm + kso1) = kr1;
  *(uint2*)(sm + vso0) = uint2{vr0.x, vr0.y}; *(uint2*)(sm + vso0 + 4) = uint2{vr0.z, vr0.w};
  __syncthreads();
  for (int kt = 0; kt < ntiles; ++kt) {
    const bool more = (kt + 1 < ntiles);
    if (more) {
      const u16* kg = Kb + (size_t)(kt + 1) * 64 * 96;
      kr0 = *(const uint4*)(kg + (size_t)kid0 * 8); kr1 = *(const uint4*)(kg + (size_t)kid1 * 8);
      vr0 = *(const uint4*)(vg0 + (kt + 1) * 64);
    }
    __builtin_amdgcn_sched_barrier(0);
    if (kt <= mylast) {
      const u16* Ks = sm + (kt & 1) * ABUF;
      const u16* Vs = Ks + 64 * KST;
#pragma unroll 1
      for (int sub = 0; sub < 2; ++sub) {
        f32x16 s0, s1;
#pragma unroll
        for (int e = 0; e < 16; ++e) { s0[e] = 0.f; s1[e] = 0.f; }
#pragma unroll
        for (int ks = 0; ks < 6; ++ks) {
          bf16x8 kf = *(const bf16x8*)(Ks + (sub * 32 + l31) * KST + ks * 16 + hh * 8);
          s0 = __builtin_amdgcn_mfma_f32_32x32x16_bf16(kf, qf[0][ks], s0, 0, 0, 0);
          s1 = __builtin_amdgcn_mfma_f32_32x32x16_bf16(kf, qf[1][ks], s1, 0, 0, 0);
        }
        uint4 pk0[2], pk1[2];
        {
          float e0[16], e1[16];
#pragma unroll
          for (int e = 0; e < 16; ++e) {
            e0[e] = __builtin_amdgcn_exp2f(s0[e]); e1[e] = __builtin_amdgcn_exp2f(s1[e]);
            lsum[0] += e0[e]; lsum[1] += e1[e];
          }
#pragma unroll
          for (int kk = 0; kk < 2; ++kk) {
            pk0[kk] = uint4{pack2(e0[8 * kk], e0[8 * kk + 1]), pack2(e0[8 * kk + 2], e0[8 * kk + 3]), pack2(e0[8 * kk + 4], e0[8 * kk + 5]), pack2(e0[8 * kk + 6], e0[8 * kk + 7])};
            pk1[kk] = uint4{pack2(e1[8 * kk], e1[8 * kk + 1]), pack2(e1[8 * kk + 2], e1[8 * kk + 3]), pack2(e1[8 * kk + 4], e1[8 * kk + 5]), pack2(e1[8 * kk + 6], e1[8 * kk + 7])};
          }
        }
#pragma unroll
        for (int kk = 0; kk < 2; ++kk) {
          const bf16x8 p0 = __builtin_bit_cast(bf16x8, pk0[kk]);
          const bf16x8 p1 = __builtin_bit_cast(bf16x8, pk1[kk]);
#pragma unroll
          for (int vt = 0; vt < 2; ++vt) {
            const u16* vp = Vs + (vt * 32 + l31) * VST + sub * 32 + kk * 16 + 4 * hh;
            uint2 lo = *(const uint2*)vp, hi = *(const uint2*)(vp + 8);
            const bf16x8 vf = __builtin_bit_cast(bf16x8, uint4{lo.x, lo.y, hi.x, hi.y});
            o[vt][0] = __builtin_amdgcn_mfma_f32_32x32x16_bf16(vf, p0, o[vt][0], 0, 0, 0);
            o[vt][1] = __builtin_amdgcn_mfma_f32_32x32x16_bf16(vf, p1, o[vt][1], 0, 0, 0);
          }
        }
      }
    }
    __builtin_amdgcn_sched_barrier(0);
    if (more) {
      u16* kw = sm + ((kt + 1) & 1) * ABUF;
      *(uint4*)(kw + kso0) = kr0; if (k2) *(uint4*)(kw + kso1) = kr1;
      *(uint2*)(kw + vso0) = uint2{vr0.x, vr0.y}; *(uint2*)(kw + vso0 + 4) = uint2{vr0.z, vr0.w};
    }
    __syncthreads();
  }
  if (mylast >= 0) {
#pragma unroll
    for (int qt = 0; qt < 2; ++qt) {
      float l = lsum[qt] + __shfl_xor(lsum[qt], 32);
      const float inv = 1.f / l;
      const int tok = qtok0 + qt * 32 + l31;
#pragma unroll
      for (int vt = 0; vt < 2; ++vt)
#pragma unroll
        for (int g = 0; g < 4; ++g) {
          const int vd = vt * 32 + 8 * g + 4 * hh;
          uint2 w = {pack2(o[vt][qt][4 * g] * inv, o[vt][qt][4 * g + 1] * inv), pack2(o[vt][qt][4 * g + 2] * inv, o[vt][qt][4 * g + 3] * inv)};
          *(uint2*)(mix + (size_t)tok * 1024 + h * 64 + vd) = w;
        }
    }
  }
}

#ifndef MIX_SUB
#define MIX_SUB 3
#endif
DI void mixer_phase(const P& p, char* smem) {
  const int G = gridDim.x, b = blockIdx.x;
  if (MIX_SUB & 1) {
  for (int round = 0;; ++round) {
    int rank = round * G + ((round & 1) ? (G - 1 - b) : b);
    if (round * G >= 1024) break;
    if (rank < 1024) {
      int qb = 15 - (rank >> 6), bh = rank & 63;
      attn_item(p, bh >> 3, bh & 7, qb, smem);
    }
  }
  for (int it = G - 1 - b; it < 64; it += G) attn_item(p, 8 + (it >> 3), it & 7, 0, smem);
  }
  if (MIX_SUB & 2)
  for (int it = 2 * b + (threadIdx.x >> 8); it < 4128; it += 2 * G) gla_passC(p, it, smem + (threadIdx.x >> 8) * 69632);
}

DI void fixup_phase(const P& p) {
  const float* first = (const float*)(p.ws + W_FIRST);
  const float* last = (const float*)(p.ws + W_LAST);
  u16* act = (u16*)(p.ws + W_ACT);
  for (int e = blockIdx.x * 512 + threadIdx.x; e < 1032 * 2816; e += gridDim.x * 512) {
    const int seg = e / 2816, ch = e - seg * 2816;
    float2 f0 = *(const float2*)(first + ((size_t)(seg * 2 + 0) * 2816 + ch) * 2);
    float2 f1 = *(const float2*)(first + ((size_t)(seg * 2 + 1) * 2816 + ch) * 2);
    float p0 = 0.f, p1 = 0.f;
    if (seg >= 1024) { p0 = p.state_conv[(size_t)((seg - 1024) * 2 + 0) * 2816 + ch]; p1 = p.state_conv[(size_t)((seg - 1024) * 2 + 1) * 2816 + ch]; }
    else if ((seg & 127) != 0) { p0 = last[(size_t)((seg - 1) * 2 + 0) * 2816 + ch]; p1 = last[(size_t)((seg - 1) * 2 + 1) * 2816 + ch]; }
    const float w0 = p.w_conv[ch], w1 = p.w_conv[2816 + ch], w2 = p.w_conv[5632 + ch], bb = p.b_conv[ch];
    float c0 = bb + w0 * p0 + w1 * p1 + w2 * f0.x;
    float c1 = bb + w0 * p1 + w1 * f0.x + w2 * f1.x;
    act[(size_t)(seg * 64) * 2816 + ch] = (u16)(pack2(gelu_tanh(c0) * f0.y, 0.f) & 0xffffu);
    act[(size_t)(seg * 64 + 1) * 2816 + ch] = (u16)(pack2(gelu_tanh(c1) * f1.y, 0.f) & 0xffffu);
  }
}

#ifndef ONLY_PH
#define ONLY_PH -1
#endif
#define PH_EN(n) (ONLY_PH < 0 || ONLY_PH == (n))
__global__ void __launch_bounds__(512, 2) mega(P p, int ph_lo, int ph_hi) {
  __shared__ __attribute__((aligned(16))) char smem[147456];
  cg::grid_group grid = cg::this_grid();
  const float* mods = (const float*)(p.ws + W_MODS);
  const float2* rope = (const float2*)(p.ws + W_ROPE);
#ifndef DUP_PH
#define DUP_PH -1
#endif
#define PHASE(n, ...) if (PH_EN(n) && ph_lo <= (n) && (n) <= ph_hi) { { __VA_ARGS__ } if (DUP_PH == (n)) { __VA_ARGS__ } } if (ph_lo <= (n) && (n) < ph_hi) grid.sync();
  PHASE(0, phase0(p, smem);)
  PHASE(1, prenorm_phase(p, false, p.g_norm1, 0, 1);)
  PHASE(2, { EpiProj e{(u16*)(p.ws + W_PROJ)};
             gemm_phase((const u16*)(p.ws + W_H), 1024, (const u16*)(p.ws + W_WIN), 1024, 258, 9, e, smem, 0); })
  PHASE(3, { rowlocal_phase(p);
             for (int it = 2 * blockIdx.x + (threadIdx.x >> 8); it < 4128; it += 2 * gridDim.x) gla_passA(p, it, smem + (threadIdx.x >> 8) * 69632); })
  PHASE(4, { EpiQ e{(u16*)(p.ws + W_QF), p.g_qn, rope};
             gemm_phase((const u16*)(p.ws + W_QN), 384, (const u16*)(p.ws + W_WUQ), 384, 258, 4, e, smem, 0);
             EpiKV e2{(u16*)(p.ws + W_KF), (u16*)(p.ws + W_VTP), (u16*)(p.ws + W_VTS), (const float*)(p.ws + W_KPE), p.g_kn, rope};
             gemm_phase((const u16*)(p.ws + W_CKVB), 256, (const u16*)(p.ws + W_WUKV), 256, 290, 4, e2, smem, 8);
             gla_passB(p); })
  PHASE(5, mixer_phase(p, smem);)
  PHASE(6, { EpiRes e{&p, nullptr, (float*)(p.ws + W_X1), mods, 2};
             gemm_phase((const u16*)(p.ws + W_H), 1024, (const u16*)(p.ws + W_WOUT), 1024, 258, 4, e, smem, 0); })
  PHASE(7, prenorm_phase(p, true, p.g_norm2, 3, 4);)
#ifndef PROBE_MODE
#define PROBE_MODE 0
#endif
  PHASE(8, { EpiUp e{(u16*)(p.ws + W_ACT), (float*)(p.ws + W_FIRST), (float*)(p.ws + W_LAST), p.w_conv, p.b_conv, p.out};
             if (PROBE_MODE) gemm_phase<PROBE_MODE>((const u16*)(p.ws + W_H), 1024, (const u16*)(p.ws + W_WUP), 1024, 258, 22, e, smem, 0);
             gemm_phase((const u16*)(p.ws + W_H), 1024, (const u16*)(p.ws + W_WUP), 1024, 258, 22, e, smem, 0); })
  PHASE(9, fixup_phase(p);)
  PHASE(10, { EpiRes e{&p, (const float*)(p.ws + W_X1), p.out + O_Y, mods, 5};
              gemm_phase((const u16*)(p.ws + W_ACT), 2816, (const u16*)(p.ws + W_WDN), 2816, 258, 4, e, smem, 0); })
}

extern "C" void kernel_launch(void* const* d_in, const int* in_sizes, int n_in, void* d_out, int out_size, void* d_ws,
                              size_t ws_size, hipStream_t stream) {
  static int grid_blocks = 0;
  if (!grid_blocks) {
    int dev = 0, cus = 0, per_cu = 0;
    hipGetDevice(&dev);
    hipDeviceGetAttribute(&cus, hipDeviceAttributeMultiprocessorCount, dev);
    hipOccupancyMaxActiveBlocksPerMultiprocessor(&per_cu, mega, 512, 0);
    if (per_cu < 1) per_cu = 1;
    if (per_cu > 1) per_cu = 1;
    grid_blocks = cus * per_cu;
  }
  P p{};
  const float** f = (const float**)&p;
  for (int i = 0; i < 27; ++i) f[i] = (const float*)d_in[i];
  p.out = (float*)d_out;
  p.ws = (char*)d_ws;
  int lo = 0, hi = 10;
  void* args[] = {&p, &lo, &hi};
  hipError_t e = hipLaunchCooperativeKernel((void*)mega, dim3(grid_blocks), dim3(512), args, 0, stream);
  if (e != hipSuccess) fprintf(stderr, "cooperative launch failed: %s (grid %d)\n", hipGetErrorString(e), grid_blocks);
}
```

```cpp
#include <hip/hip_runtime.h>
#include <hip/hip_cooperative_groups.h>
#include <cstdio>
namespace cg = cooperative_groups;

typedef unsigned short u16;
typedef unsigned int u32;
using bf16x8 = __attribute__((ext_vector_type(8))) short;
using f32x4 = __attribute__((ext_vector_type(4))) float;
using f32x16 = __attribute__((ext_vector_type(16))) float;
typedef __bf16 bf2_t __attribute__((ext_vector_type(2)));
typedef float fl2_t __attribute__((ext_vector_type(2)));
#define DI __device__ __forceinline__

constexpr int NTOK = 66048;
constexpr int NPTOK = 65536;
constexpr int G3ROWS = 74240;
constexpr int PROJ_LD = 2224;
constexpr int C_KV = 384, C_KPE = 640, C_GQ = 672, C_GK = 928, C_GV = 1184, C_LR = 1696, C_OG = 1712;
constexpr float EPS = 1e-6f;

constexpr size_t O_Y = 0;
constexpr size_t O_CKVP = 67108864 + 524288;
constexpr size_t O_KPEP = O_CKVP + 16777216;
constexpr size_t O_GLAP = O_KPEP + 2097152;
constexpr size_t O_CONVP = O_GLAP + 262144;
constexpr size_t O_CKVS = O_CONVP + 45056;
constexpr size_t O_KPES = O_CKVS + 131072;
constexpr size_t O_GLAS = O_KPES + 16384;
constexpr size_t O_CONVS = O_GLAS + 262144;

constexpr size_t al256(size_t x) { return (x + 255) & ~size_t(255); }
constexpr size_t W_MODS = 0;
constexpr size_t W_ROPE = W_MODS + al256(16 * 6144 * 4);
constexpr size_t W_WIN = W_ROPE + al256(8192 * 16 * 8);
constexpr size_t W_WUQ = W_WIN + al256((size_t)2304 * 1024 * 2);
constexpr size_t W_WUKV = W_WUQ + al256((size_t)1024 * 384 * 2);
constexpr size_t W_WOUT = W_WUKV + al256((size_t)1024 * 256 * 2);
constexpr size_t W_WUP = W_WOUT + al256((size_t)1024 * 1024 * 2);
constexpr size_t W_WDN = W_WUP + al256((size_t)5632 * 1024 * 2);
constexpr size_t W_KPE = W_WDN + al256((size_t)1024 * 2816 * 2);
constexpr size_t W_DBUF = W_KPE + al256((size_t)G3ROWS * 32 * 4);
constexpr size_t W_H = W_DBUF + al256((size_t)4096 * 64 * 4);
constexpr size_t W_RA = W_H + al256((size_t)NTOK * 1024 * 2);
constexpr size_t W_PROJ = W_RA;
constexpr size_t W_QN = W_PROJ + al256((size_t)NTOK * PROJ_LD * 2);
constexpr size_t W_CKVB = W_QN + al256((size_t)NTOK * 384 * 2);
constexpr size_t W_RA_END = W_CKVB + al256((size_t)G3ROWS * 256 * 2);
constexpr size_t W_ACT = W_RA;
constexpr size_t W_RB = W_RA_END;
constexpr size_t W_QF = W_RB;
constexpr size_t W_KF = W_QF + al256((size_t)NTOK * 768 * 2);
constexpr size_t W_VTP = W_KF + al256((size_t)8 * G3ROWS * 96 * 2);
constexpr size_t W_VTS = W_VTP + al256((size_t)64 * 64 * 8192 * 2);
constexpr size_t W_RB_END = W_VTS + al256((size_t)64 * 64 * 1088 * 2);
constexpr size_t W_X1 = W_RB;
constexpr size_t W_U = W_RB_END;
constexpr size_t W_FIRST = W_U;
constexpr size_t W_LAST = W_FIRST + al256((size_t)1032 * 2 * 2816 * 2 * 4);
constexpr size_t W_END = W_U + (size_t)4096 * 8192 * 4;
static_assert(W_ACT + (size_t)NTOK * 2816 * 2 <= W_RA_END, "act alias");
static_assert(W_X1 + (size_t)NTOK * 1024 * 4 <= W_RB_END, "x1 alias");
static_assert(W_LAST + (size_t)1032 * 2 * 2816 * 4 <= W_END, "first/last alias");
constexpr size_t W_GVT = W_END;
constexpr size_t W_GVTS = W_GVT + (size_t)32 * 128 * 8192 * 2;
constexpr size_t W_END2 = W_GVTS + (size_t)32 * 128 * 64 * 2;
static_assert(W_END2 <= (size_t)1073741824, "workspace");

struct P {
  const float *x_prompt, *x_sample, *c_prompt, *c_sample, *cache_ckv, *cache_kpe, *state_gla, *state_conv;
  const float *w_ada, *b_ada, *g_norm1, *w_in, *g_qa, *w_uq, *g_qn, *g_kva, *w_ukv, *g_kn, *w_a2, *b_a2, *g_gla,
      *w_out, *g_norm2, *w_up, *w_conv, *b_conv, *w_down;
  float* out;
  char* ws;
};

DI u32 pack2(float a, float b) { fl2_t v = {a, b}; bf2_t r = __builtin_convertvector(v, bf2_t); return __builtin_bit_cast(u32, r); }
DI float bflo(u32 u) { return __uint_as_float(u << 16); }
DI float bfhi(u32 u) { return __uint_as_float(u & 0xffff0000u); }
DI float wave_sum(float v) {
#pragma unroll
  for (int o = 32; o > 0; o >>= 1) v += __shfl_xor(v, o);
  return v;
}
DI int tok_seq(int r) { return r < NPTOK ? (r >> 13) : 8 + ((r - NPTOK) >> 6); }
DI int tok_pos(int r) { return r < NPTOK ? (r & 8191) : 1024 + ((r - NPTOK) & 63); }
DI int tok_g3row(int r) { return r < NPTOK ? r : NPTOK + ((r - NPTOK) >> 6) * 1088 + 1024 + ((r - NPTOK) & 63); }
DI const float* x_row(const P& p, int r) { return r < NPTOK ? p.x_prompt + (size_t)r * 1024 : p.x_sample + (size_t)(r - NPTOK) * 1024; }
DI float silu_f(float x) { return x / (1.f + __expf(-x)); }
DI float gelu_tanh(float x) {
  float x2 = x * x;
  float w = x * (-2.302208198f - 0.1029432397f * x2);
  return x * __builtin_amdgcn_rcpf(1.f + __builtin_amdgcn_exp2f(w));
}
DI void unpack8(uint4 v, float* d) {
  d[0] = bflo(v.x); d[1] = bfhi(v.x); d[2] = bflo(v.y); d[3] = bfhi(v.y);
  d[4] = bflo(v.z); d[5] = bfhi(v.z); d[6] = bflo(v.w); d[7] = bfhi(v.w);
}

DI void ph0_mods(const P& p, int unit, float* sm) {
  const int t = threadIdx.x;
  for (int i = t; i < 16 * 1024; i += 512) {
    int s = i >> 10, k = i & 1023;
    float c = (s < 8) ? p.c_prompt[s * 1024 + k] : p.c_sample[(s - 8) * 1024 + k];
    sm[k * 16 + s] = c / (1.f + expf(-c));
  }
  __syncthreads();
  const int col = unit * 64 + (t & 63), kq = t >> 6;
  float acc[16];
#pragma unroll
  for (int s = 0; s < 16; ++s) acc[s] = 0.f;
#pragma unroll 8
  for (int k = kq * 128; k < kq * 128 + 128; ++k) {
    float w = p.w_ada[(size_t)k * 6144 + col];
    const float4* sp = (const float4*)(sm + k * 16);
    float4 a0 = sp[0], a1 = sp[1], a2 = sp[2], a3 = sp[3];
    acc[0] += a0.x * w; acc[1] += a0.y * w; acc[2] += a0.z * w; acc[3] += a0.w * w;
    acc[4] += a1.x * w; acc[5] += a1.y * w; acc[6] += a1.z * w; acc[7] += a1.w * w;
    acc[8] += a2.x * w; acc[9] += a2.y * w; acc[10] += a2.z * w; acc[11] += a2.w * w;
    acc[12] += a3.x * w; acc[13] += a3.y * w; acc[14] += a3.z * w; acc[15] += a3.w * w;
  }
  __syncthreads();
#pragma unroll
  for (int s = 0; s < 16; ++s) sm[(kq * 16 + s) * 64 + (t & 63)] = acc[s];
  __syncthreads();
  float* mods = (float*)(p.ws + W_MODS);
  for (int i = t; i < 16 * 64; i += 512) {
    int s = i >> 6, c = i & 63;
    float v = p.b_ada[unit * 64 + c];
#pragma unroll
    for (int q = 0; q < 8; ++q) v += sm[(q * 16 + s) * 64 + c];
    mods[s * 6144 + unit * 64 + c] = v;
  }
  __syncthreads();
}

DI void ph0_transpose(const float* __restrict__ W, int K, int N, u16* __restrict__ Wt, int mode, int kt, int nt, float* sm) {
  const int t = threadIdx.x;
  const int n0 = nt * 64, k0 = kt * 64;
  int src0, nvalid = 64;
  if (mode == 0) { src0 = n0; nvalid = N - n0; }
  else if (mode == 1) { int h = n0 >> 7, c = n0 & 127; src0 = h * 96 + c; nvalid = 96 - c; }
  else { int j = n0 >> 7, c = n0 & 127; src0 = (c < 64) ? j * 64 : 2816 + j * 64; }
  const int col = t & 63;
#pragma unroll
  for (int i = 0; i < 8; ++i) {
    int k = (t >> 6) + 8 * i;
    float v = (col < nvalid) ? W[(size_t)(k0 + k) * N + src0 + col] : 0.f;
    sm[k * 65 + col] = v;
  }
  __syncthreads();
  {
    int id = t, n = id >> 3, kc = id & 7;
    const float* s = sm + (kc * 8) * 65 + n;
    uint4 o;
    o.x = pack2(s[0], s[65]); o.y = pack2(s[130], s[195]); o.z = pack2(s[260], s[325]); o.w = pack2(s[390], s[455]);
    *(uint4*)(Wt + (size_t)(n0 + n) * K + k0 + kc * 8) = o;
  }
  __syncthreads();
}

DI void phase0(const P& p, char* smem) {
  float* sm = (float*)smem;
  const int t = threadIdx.x;
  constexpr int U_MODS = 96, U_WIN = 576, U_WUQ = 96, U_WUKV = 64, U_WOUT = 256, U_WUP = 1408, U_WDN = 704, U_CKV = 128, U_KPE = 16, U_ROPE = 8;
  constexpr int TOTAL = U_MODS + U_WIN + U_WUQ + U_WUKV + U_WOUT + U_WUP + U_WDN + U_CKV + U_KPE + U_ROPE;
  for (int u0 = blockIdx.x; u0 < TOTAL; u0 += gridDim.x) {
    int u = u0;
    if (u < U_MODS) { ph0_mods(p, u, sm); continue; }
    u -= U_MODS;
    if (u < U_WIN) { ph0_transpose(p.w_in, 1024, 2224, (u16*)(p.ws + W_WIN), 0, u / 36, u % 36, sm); continue; }
    u -= U_WIN;
    if (u < U_WUQ) { ph0_transpose(p.w_uq, 384, 768, (u16*)(p.ws + W_WUQ), 1, u / 16, u % 16, sm); continue; }
    u -= U_WUQ;
    if (u < U_WUKV) { ph0_transpose(p.w_ukv, 256, 1024, (u16*)(p.ws + W_WUKV), 0, u / 16, u % 16, sm); continue; }
    u -= U_WUKV;
    if (u < U_WOUT) { ph0_transpose(p.w_out, 1024, 1024, (u16*)(p.ws + W_WOUT), 0, u / 16, u % 16, sm); continue; }
    u -= U_WOUT;
    if (u < U_WUP) { ph0_transpose(p.w_up, 1024, 5632, (u16*)(p.ws + W_WUP), 2, u / 88, u % 88, sm); continue; }
    u -= U_WUP;
    if (u < U_WDN) { ph0_transpose(p.w_down, 2816, 1024, (u16*)(p.ws + W_WDN), 0, u / 16, u % 16, sm); continue; }
    u -= U_WDN;
    if (u < U_CKV) {
      u16* ckvb = (u16*)(p.ws + W_CKVB);
#pragma unroll
      for (int i = 0; i < 4; ++i) {
        int id = t + 512 * i;
        int row = u * 64 + (id >> 5), c8 = id & 31;
        int sb = row >> 10, pp = row & 1023;
        const float4* src = (const float4*)(p.cache_ckv + (size_t)row * 256 + c8 * 8);
        float4 a = src[0], b = src[1];
        uint4 o = {pack2(a.x, a.y), pack2(a.z, a.w), pack2(b.x, b.y), pack2(b.z, b.w)};
        *(uint4*)(ckvb + (size_t)(NPTOK + sb * 1088 + pp) * 256 + c8 * 8) = o;
      }
      continue;
    }
    u -= U_CKV;
    if (u < U_KPE) {
      float* kpa = (float*)(p.ws + W_KPE);
#pragma unroll
      for (int i = 0; i < 8; ++i) {
        int id = t + 512 * i;
        int row = u * 512 + (id >> 3), c4 = id & 7;
        int sb = row >> 10, pp = row & 1023;
        float4 v = *(const float4*)(p.cache_kpe + (size_t)row * 32 + c4 * 4);
        *(float4*)(kpa + (size_t)(NPTOK + sb * 1088 + pp) * 32 + c4 * 4) = v;
      }
      continue;
    }
    u -= U_KPE;
    {
      float2* rope = (float2*)(p.ws + W_ROPE);
      for (int i = 0; i < 32; ++i) {
        int e = u * 16384 + i * 512 + t;
        int pos = e >> 4, idx = e & 15;
        int q = idx >> 2, r = idx & 3;
        float base = (r == 0) ? 1.f : (r == 1) ? 0.5623413251903491f : (r == 2) ? 0.31622776601683794f : 0.1778279410038923f;
        float sc = (q == 0) ? 1.f : (q == 1) ? 0.1f : (q == 2) ? 0.01f : 0.001f;
        float inv = base * sc;
        float ang = (float)pos * inv;
        double rev = (double)ang * 0.15915494309189535;
        rev -= floor(rev);
        float fr = (float)rev;
        rope[e] = make_float2(__builtin_amdgcn_cosf(fr), __builtin_amdgcn_sinf(fr));
      }
    }
  }
}

DI void prenorm_phase(const P& p, bool from_x1, const float* __restrict__ g, int shift_idx, int scale_idx) {
  const int lane = threadIdx.x & 63, wave = threadIdx.x >> 6;
  const float* mods = (const float*)(p.ws + W_MODS);
  u16* hb = (u16*)(p.ws + W_H);
  const float* x1 = (const float*)(p.ws + W_X1);
  for (int r = blockIdx.x * 8 + wave; r < NTOK; r += gridDim.x * 8) {
    const float* xr = from_x1 ? x1 + (size_t)r * 1024 : x_row(p, r);
    const int s = tok_seq(r);
    float4 v[4];
    float ss = 0.f;
#pragma unroll
    for (int i = 0; i < 4; ++i) {
      v[i] = ((const float4*)xr)[lane + 64 * i];
      ss += v[i].x * v[i].x + v[i].y * v[i].y + v[i].z * v[i].z + v[i].w * v[i].w;
    }
    ss = wave_sum(ss);
    const float rstd = rsqrtf(ss * (1.f / 1024.f) + EPS);
#pragma unroll
    for (int i = 0; i < 4; ++i) {
      int col = (lane + 64 * i) * 4;
      float4 gg = *(const float4*)(g + col);
      float4 sc = *(const float4*)(mods + s * 6144 + scale_idx * 1024 + col);
      float4 sh = *(const float4*)(mods + s * 6144 + shift_idx * 1024 + col);
      float a = v[i].x * rstd * gg.x * (1.f + sc.x) + sh.x;
      float b = v[i].y * rstd * gg.y * (1.f + sc.y) + sh.y;
      float c = v[i].z * rstd * gg.z * (1.f + sc.z) + sh.z;
      float d = v[i].w * rstd * gg.w * (1.f + sc.w) + sh.w;
      uint2 o = {pack2(a, b), pack2(c, d)};
      *(uint2*)(hb + (size_t)r * 1024 + col) = o;
    }
  }
}

constexpr int LDSK = 72;
constexpr int CTS = 132;

template <int MODE = 0, class Epi>
DI void gemm_phase(const u16* __restrict__ A, int lda, const u16* __restrict__ Bt, int K, int mtiles, int ntiles, const Epi& epi,
                   char* smem, int rot) {
  constexpr int GLK = 64;
  u16* As = (u16*)smem;
  u16* Bs = As + 2 * 256 * GLK;
  const int t = threadIdx.x, lane = t & 63, wave = t >> 6, wr = wave >> 2, wc = wave & 3;
  const int fr = lane & 15, fq = lane >> 4;
  const int nk = K >> 6;
  const int total = mtiles * ntiles;
  const int G = gridDim.x;
  const int srow = t >> 3, skc = (t & 7) * 8;
  const int swc = ((t & 7) ^ ((srow >> 1) & 7)) * 8;
  const int fsw = (fr >> 1) & 7;
  const int ro0 = ((fq ^ fsw) * 8), ro1 = (((fq ^ fsw) ^ 4) * 8);
  const int bb = ((int)blockIdx.x - (rot % G) + G) % G;
  const bool swz = ((G & 7) == 0);
  const int chunk = G >> 3;
  for (int r = 0; r * G < total; ++r) {
    const int item = swz ? ((r * 8 + (bb & 7)) * chunk + (bb >> 3)) : (r * G + bb);
    if (item >= total) continue;
    const int band = item / (8 * ntiles), rem = item - band * 8 * ntiles;
    const int bhgt = min(8, mtiles - band * 8);
    const int nt = rem / bhgt, mt = band * 8 + (rem - nt * bhgt);
    const u16* Ag = A + (size_t)(mt * 256) * lda;
    const u16* Bg = Bt + (size_t)(nt * 256) * K;
    const int voa = srow * lda + swc, vob = srow * K + swc;
    f32x4 acc[8][4];
#pragma unroll
    for (int i = 0; i < 8; ++i)
#pragma unroll
      for (int j = 0; j < 4; ++j) acc[i][j] = f32x4{0.f, 0.f, 0.f, 0.f};
    char* const la = (char*)As + t * 16;
    char* const lb = (char*)Bs + t * 16;
#define GLDS16(gp, lp) __builtin_amdgcn_global_load_lds((const unsigned*)(gp), (unsigned*)(lp), 16, 0, 0)
#pragma unroll
    for (int i = 0; i < 4; ++i) {
      GLDS16(Ag + (size_t)(64 * i) * lda + voa, la + i * 8192);
      GLDS16(Bg + (size_t)(64 * i) * K + vob, lb + i * 8192);
    }
    __syncthreads();
    for (int kt = 0; kt < nk; ++kt) {
      const bool more = (MODE == 2) ? false : (kt + 1 < nk);
      if (more) {
        const u16* ag = Ag + (kt + 1) * 64;
        const u16* bg = Bg + (kt + 1) * 64;
        const int bo = ((kt + 1) & 1) * 32768;
#pragma unroll
        for (int i = 0; i < 4; ++i) {
          GLDS16(ag + (size_t)(64 * i) * lda + voa, la + bo + i * 8192);
          GLDS16(bg + (size_t)(64 * i) * K + vob, lb + bo + i * 8192);
        }
      }
      __builtin_amdgcn_sched_barrier(0);
      const u16* as = As + (kt & 1) * 256 * GLK + (wr * 128 + fr) * GLK;
      const u16* bs = Bs + (kt & 1) * 256 * GLK + (wc * 64 + fr) * GLK;
      bf16x8 bc[4], bn[4], ac[2], an[2];
#pragma unroll
      for (int j = 0; j < 4; ++j) bc[j] = *(const bf16x8*)(bs + j * 16 * GLK + ro0);
#pragma unroll
      for (int i = 0; i < 2; ++i) ac[i] = *(const bf16x8*)(as + i * 16 * GLK + ro0);
#pragma unroll
      for (int g = 0; g < 8; ++g) {
        const int ih = g & 3;
        if (g < 7) {
          const int gn = g + 1;
#pragma unroll
          for (int i = 0; i < 2; ++i) an[i] = *(const bf16x8*)(as + ((gn & 3) * 2 + i) * 16 * GLK + ((gn >> 2) ? ro1 : ro0));
        }
        if (g == 3) {
#pragma unroll
          for (int j = 0; j < 4; ++j) bn[j] = *(const bf16x8*)(bs + j * 16 * GLK + ro1);
        }
#pragma unroll
        for (int i = 0; i < 2; ++i)
#pragma unroll
          for (int j = 0; j < 4; ++j) acc[ih * 2 + i][j] = __builtin_amdgcn_mfma_f32_16x16x32_bf16(bc[j], ac[i], acc[ih * 2 + i][j], 0, 0, 0);
        __builtin_amdgcn_sched_barrier(0);
        ac[0] = an[0]; ac[1] = an[1];
        if (g == 3) {
#pragma unroll
          for (int j = 0; j < 4; ++j) bc[j] = bn[j];
        }
      }
      __syncthreads();
    }
    if (MODE != 0) {
      float sum = 0.f;
#pragma unroll
      for (int i = 0; i < 8; ++i)
#pragma unroll
        for (int j = 0; j < 4; ++j) sum += acc[i][j][0] + acc[i][j][1] + acc[i][j][2] + acc[i][j][3];
      if (sum == 123456.789f) ((float*)smem)[t] = sum;
      continue;
    }
#pragma unroll
    for (int bj = 0; bj < 2; ++bj) {
      if ((wc >> 1) == bj) {
        float* cw = (float*)smem + wr * (128 * CTS) + fr * CTS + (wc & 1) * 64 + fq * 4;
#pragma unroll
        for (int i = 0; i < 8; ++i)
#pragma unroll
          for (int j = 0; j < 4; ++j) *(f32x4*)(cw + i * 16 * CTS + j * 16) = acc[i][j];
      }
      __syncthreads();
      {
        int te = t;
        asm volatile("" : "+v"(te));
        const float* Ce = (const float*)smem + (te >> 8) * (128 * CTS);
        epi(mt * 2 + (te >> 8), nt * 2 + bj, Ce, te & 255);
      }
      __syncthreads();
    }
  }
}

struct EpiProj {
  u16* proj; u16* gvt; u16* gvts;
  DI void operator()(int mt, int nt, const float* Ct, const int t) const {
#pragma unroll 2
    for (int i = 0; i < 8; ++i) {
      int id = t + 256 * i, row = id >> 4, c8 = id & 15;
      int col = nt * 128 + c8 * 8;
      if (col < PROJ_LD) {
        const float* c = Ct + row * CTS + c8 * 8;
        float4 a = *(const float4*)c, b = *(const float4*)(c + 4);
        uint4 o = {pack2(a.x, a.y), pack2(a.z, a.w), pack2(b.x, b.y), pack2(b.z, b.w)};
        *(uint4*)(proj + (size_t)(mt * 128 + row) * PROJ_LD + col) = o;
      }
    }
    if (nt >= 9 && nt <= 13) {
#pragma unroll 1
      for (int i = 0; i < 8; ++i) {
        int id = t + 256 * i, rg = id & 15, cc = id >> 4;
        int col = nt * 128 + cc;
        if (col >= C_GV && col < C_LR) {
          const int eg = col - C_GV, hd = eg >> 7, e = eg & 127;
          const float* c = Ct + ((rg >> 1) * 16 + (rg & 1) * 4) * CTS + cc;
          uint4 o = {pack2(c[0], c[CTS]), pack2(c[2 * CTS], c[3 * CTS]), pack2(c[8 * CTS], c[9 * CTS]), pack2(c[10 * CTS], c[11 * CTS])};
          const int r0 = mt * 128 + rg * 8;
          u16* d;
          if (r0 < NPTOK) d = gvt + ((size_t)(((r0 >> 13) * 4 + hd) * 128 + e)) * 8192 + (r0 & 8191);
          else { int rr = r0 - NPTOK; d = gvts + ((size_t)(((rr >> 6) * 4 + hd) * 128 + e)) * 64 + (rr & 63); }
          *(uint4*)d = o;
        }
      }
    }
  }
};

struct EpiQ {
  u16* Qf; const float* g_qn; const float2* rope;
  DI void operator()(int mt, int nt, const float* Ct, const int t) const {
    const int row = t >> 1, half = t & 1;
    const int r = mt * 128 + row;
    const float QS = 0.14724445f;
    const float* c = Ct + row * CTS + half * 48;
    float ss = 0.f;
#pragma unroll 4
    for (int i = 0; i < 12; ++i) {
      float4 x = *(const float4*)(c + 4 * i);
      ss += x.x * x.x + x.y * x.y + x.z * x.z + x.w * x.w;
    }
    ss += __shfl_xor(ss, 1);
    const float rs = rsqrtf(ss * (1.f / 96.f) + EPS) * QS;
    u16* dst = Qf + ((size_t)r * 8 + nt) * 96 + half * 48;
    const float* g = g_qn + half * 48;
    const int nplain = half ? 2 : 6;
#pragma unroll 1
    for (int i = 0; i < nplain; ++i) {
      float4 x0 = *(const float4*)(c + 8 * i), x1 = *(const float4*)(c + 8 * i + 4);
      float4 g0 = *(const float4*)(g + 8 * i), g1 = *(const float4*)(g + 8 * i + 4);
      uint4 o = {pack2(x0.x * rs * g0.x, x0.y * rs * g0.y), pack2(x0.z * rs * g0.z, x0.w * rs * g0.w),
                 pack2(x1.x * rs * g1.x, x1.y * rs * g1.y), pack2(x1.z * rs * g1.z, x1.w * rs * g1.w)};
      *(uint4*)(dst + 8 * i) = o;
    }
    if (half) {
      const int pos = tok_pos(r);
#pragma unroll 1
      for (int mg = 0; mg < 4; ++mg) {
        float o1[4], o2[4];
#pragma unroll
        for (int m = 0; m < 4; ++m) {
          const int mm = mg * 4 + m;
          float n1 = c[16 + mm] * rs * g_qn[64 + mm], n2 = c[32 + mm] * rs * g_qn[80 + mm];
          float2 cs = rope[pos * 16 + mm];
          o1[m] = n1 * cs.x - n2 * cs.y;
          o2[m] = n2 * cs.x + n1 * cs.y;
        }
        *(uint2*)(dst + 16 + mg * 4) = uint2{pack2(o1[0], o1[1]), pack2(o1[2], o1[3])};
        *(uint2*)(dst + 32 + mg * 4) = uint2{pack2(o2[0], o2[1]), pack2(o2[2], o2[3])};
      }
    }
  }
};

struct EpiKV {
  u16* Kf; u16* VtP; u16* VtS; const float* kpe_all; const float* g_kn; const float2* rope;
  DI void operator()(int mt, int nt, const float* Ct, const int t) const {
    const int row = t >> 1, half = t & 1;
    const int r = mt * 128 + row;
    int seq, pos;
    if (r < NPTOK) { seq = r >> 13; pos = r & 8191; } else { int rr = r - NPTOK; seq = 8 + rr / 1088; pos = rr - (seq - 8) * 1088; }
    u16* dst = Kf + ((size_t)nt * G3ROWS + r) * 96;
    const float* c = Ct + row * CTS;
    const float* kp = kpe_all + (size_t)r * 32;
    float ss = 0.f;
    if (half == 0) {
#pragma unroll 4
      for (int i = 0; i < 16; ++i) {
        float4 x = *(const float4*)(c + 4 * i);
        ss += x.x * x.x + x.y * x.y + x.z * x.z + x.w * x.w;
      }
    } else {
#pragma unroll 4
      for (int i = 0; i < 8; ++i) {
        float4 x = *(const float4*)(kp + 4 * i);
        ss += x.x * x.x + x.y * x.y + x.z * x.z + x.w * x.w;
      }
    }
    ss += __shfl_xor(ss, 1);
    const float rs = rsqrtf(ss * (1.f / 96.f) + EPS);
    if (half == 0) {
#pragma unroll 1
      for (int i = 0; i < 8; ++i) {
        float4 x0 = *(const float4*)(c + 8 * i), x1 = *(const float4*)(c + 8 * i + 4);
        float4 g0 = *(const float4*)(g_kn + 8 * i), g1 = *(const float4*)(g_kn + 8 * i + 4);
        uint4 o = {pack2(x0.x * rs * g0.x, x0.y * rs * g0.y), pack2(x0.z * rs * g0.z, x0.w * rs * g0.w),
                   pack2(x1.x * rs * g1.x, x1.y * rs * g1.y), pack2(x1.z * rs * g1.z, x1.w * rs * g1.w)};
        *(uint4*)(dst + 8 * i) = o;
      }
    } else {
#pragma unroll 1
      for (int mg = 0; mg < 4; ++mg) {
        float o1[4], o2[4];
#pragma unroll
        for (int m = 0; m < 4; ++m) {
          const int mm = mg * 4 + m;
          float n1 = kp[mm] * rs * g_kn[64 + mm], n2 = kp[16 + mm] * rs * g_kn[80 + mm];
          float2 cs = rope[pos * 16 + mm];
          o1[m] = n1 * cs.x - n2 * cs.y;
          o2[m] = n2 * cs.x + n1 * cs.y;
        }
        *(uint2*)(dst + 64 + mg * 4) = uint2{pack2(o1[0], o1[1]), pack2(o1[2], o1[3])};
        *(uint2*)(dst + 80 + mg * 4) = uint2{pack2(o2[0], o2[1]), pack2(o2[2], o2[3])};
      }
    }
#pragma unroll 1
    for (int i = 0; i < 4; ++i) {
      int id = t + 256 * i, rg = id & 15, vd = id >> 4;
      int r0 = mt * 128 + rg * 8;
      const float* c = Ct + ((rg >> 1) * 16 + (rg & 1) * 4) * CTS + 64 + vd;
      uint4 o = {pack2(c[0], c[CTS]), pack2(c[2 * CTS], c[3 * CTS]), pack2(c[8 * CTS], c[9 * CTS]), pack2(c[10 * CTS], c[11 * CTS])};
      u16* d;
      if (r0 < NPTOK) { int sq = r0 >> 13, p0 = r0 & 8191; d = VtP + ((size_t)((sq * 8 + nt) * 64 + vd)) * 8192 + p0; }
      else { int rr = r0 - NPTOK; int sb = rr / 1088; int p0 = rr - sb * 1088; d = VtS + ((size_t)((sb * 8 + nt) * 64 + vd)) * 1088 + p0; }
      *(uint4*)d = o;
    }
  }
};

struct EpiRes {
  const P* pp; const float* src_x1; float* dst; const float* mods; int gate_idx;
  DI void operator()(int mt, int nt, const float* Ct, const int t) const {
#pragma unroll 4
    for (int i = 0; i < 16; ++i) {
      int id = t + 256 * i, row = id >> 5, c4 = id & 31;
      int r = mt * 128 + row, col = nt * 128 + c4 * 4;
      int s = tok_seq(r);
      float4 a = *(const float4*)(Ct + row * CTS + c4 * 4);
      const float* sr = src_x1 ? src_x1 + (size_t)r * 1024 : x_row(*pp, r);
      float4 xv = *(const float4*)(sr + col);
      float4 g = *(const float4*)(mods + s * 6144 + gate_idx * 1024 + col);
      float4 o = {xv.x + g.x * a.x, xv.y + g.y * a.y, xv.z + g.z * a.z, xv.w + g.w * a.w};
      *(float4*)(dst + (size_t)r * 1024 + col) = o;
    }
  }
};

struct EpiUp {
  u16* act; float* first; float* last; const float* w_conv; const float* b_conv; float* out;
  DI void operator()(int mt, int nt, const float* Ct, const int t) const {
    const int cp = t & 31, rgp = t >> 5;
    const int ch = nt * 64 + 2 * cp;
    const float2 w0 = *(const float2*)(w_conv + ch), w1 = *(const float2*)(w_conv + 2816 + ch), w2 = *(const float2*)(w_conv + 5632 + ch);
    const float2 bb = *(const float2*)(b_conv + ch);
    const int rbase = rgp * 16;
    float2 am2 = {0.f, 0.f}, am1 = {0.f, 0.f};
    if ((rbase & 63) != 0) {
      am2 = *(const float2*)(Ct + (rbase - 2) * CTS + 2 * cp);
      am1 = *(const float2*)(Ct + (rbase - 1) * CTS + 2 * cp);
    }
#pragma unroll 1
    for (int rr = 0; rr < 16; ++rr) {
      const int row = rbase + rr;
      const float2 a = *(const float2*)(Ct + row * CTS + 2 * cp);
      const float2 g = *(const float2*)(Ct + row * CTS + 64 + 2 * cp);
      const int r = mt * 128 + row, sr = row & 63, seg = r >> 6;
      if (sr >= 2) {
        float c0 = bb.x + w0.x * am2.x + w1.x * am1.x + w2.x * a.x;
        float c1 = bb.y + w0.y * am2.y + w1.y * am1.y + w2.y * a.y;
        *(u32*)(act + (size_t)r * 2816 + ch) = pack2(gelu_tanh(c0) * g.x, gelu_tanh(c1) * g.y);
      } else {
        float4 o = {a.x, g.x, a.y, g.y};
        *(float4*)(first + ((size_t)(seg * 2 + sr) * 2816 + ch) * 2) = o;
      }
      if (sr >= 62) {
        *(float2*)(last + (size_t)(seg * 2 + (sr - 62)) * 2816 + ch) = a;
        if (seg >= 1024) *(float2*)(out + O_CONVS + (size_t)((seg - 1024) * 2 + (sr - 62)) * 2816 + ch) = a;
        else if ((seg & 127) == 127) *(float2*)(out + O_CONVP + (size_t)((seg >> 7) * 2 + (sr - 62)) * 2816 + ch) = a;
      }
      am2 = am1; am1 = a;
    }
  }
};

DI void rowlocal_phase(const P& p) {
  const int lane = threadIdx.x & 63, wave = threadIdx.x >> 6;
  const u16* proj = (const u16*)(p.ws + W_PROJ);
  u16* qn = (u16*)(p.ws + W_QN);
  u16* ckvb = (u16*)(p.ws + W_CKVB);
  float* kpa = (float*)(p.ws + W_KPE);
  for (int r = blockIdx.x * 8 + wave; r < NTOK; r += gridDim.x * 8) {
    const u16* pr = proj + (size_t)r * PROJ_LD;
    const u32* pq = (const u32*)(pr + lane * 6);
    u32 q0 = pq[0], q1 = pq[1], q2 = pq[2];
    uint2 kv = *(const uint2*)(pr + C_KV + lane * 4);
    float qv[6] = {bflo(q0), bfhi(q0), bflo(q1), bfhi(q1), bflo(q2), bfhi(q2)};
    float kk[4] = {bflo(kv.x), bfhi(kv.x), bflo(kv.y), bfhi(kv.y)};
    float sq = 0.f, sk = 0.f;
#pragma unroll
    for (int i = 0; i < 6; ++i) sq += qv[i] * qv[i];
#pragma unroll
    for (int i = 0; i < 4; ++i) sk += kk[i] * kk[i];
    sq = wave_sum(sq); sk = wave_sum(sk);
    const float rq = rsqrtf(sq * (1.f / 384.f) + EPS), rk = rsqrtf(sk * (1.f / 256.f) + EPS);
    u32* dq = (u32*)(qn + (size_t)r * 384 + lane * 6);
    const float* gq = p.g_qa + lane * 6;
    dq[0] = pack2(qv[0] * rq * gq[0], qv[1] * rq * gq[1]);
    dq[1] = pack2(qv[2] * rq * gq[2], qv[3] * rq * gq[3]);
    dq[2] = pack2(qv[4] * rq * gq[4], qv[5] * rq * gq[5]);
    float4 gk = *(const float4*)(p.g_kva + lane * 4);
    float4 cv = {kk[0] * rk * gk.x, kk[1] * rk * gk.y, kk[2] * rk * gk.z, kk[3] * rk * gk.w};
    float* co = (r < NPTOK) ? p.out + O_CKVP + (size_t)r * 256 : p.out + O_CKVS + (size_t)(r - NPTOK) * 256;
    *(float4*)(co + lane * 4) = cv;
    const int g3 = tok_g3row(r);
    uint2 cb = {pack2(cv.x, cv.y), pack2(cv.z, cv.w)};
    *(uint2*)(ckvb + (size_t)g3 * 256 + lane * 4) = cb;
    if (lane < 32) {
      float kp = __uint_as_float(((u32)pr[C_KPE + lane]) << 16);
      float* ko = (r < NPTOK) ? p.out + O_KPEP + (size_t)r * 32 : p.out + O_KPES + (size_t)(r - NPTOK) * 32;
      ko[lane] = kp;
      kpa[(size_t)g3 * 32 + lane] = kp;
    }
  }
}

constexpr int GS = 68;
DI int gperm(int j) {
  const int blk = (j >> 2) & 3;
  return (j & ~15) | ((((blk & 1) << 1) | (blk >> 1)) << 2) | (j & 3);
}
DI int swz64(int row, int col) {
  return row * 64 + ((((col >> 3) ^ (row >> 1)) & 7) << 3) + (col & 7);
}
DI void gla_prep(const P& p, const u16* proj, int r0, int h, float* sV, float* sS) {
  const int t = threadIdx.x & 255;
  if (t < 128) {
    int row = t >> 1, hf = t & 1;
    uint4 v = *(const uint4*)(proj + (size_t)(r0 + row) * PROJ_LD + C_LR + hf * 8);
    unpack8(v, sV + row * 16 + hf * 8);
  }
#pragma unroll
  for (int i = 0; i < 4; ++i) {
    int id = t + 256 * i, rr = id >> 6, d = id & 63;
    sV[1024 + id] = p.w_a2[rr * 256 + h * 64 + d];
  }
  __syncthreads();
  const int d = t & 63, tg = t >> 6;
  {
    float wv[16];
#pragma unroll
    for (int rr = 0; rr < 16; ++rr) wv[rr] = sV[1024 + rr * 64 + d];
    const float bb = p.b_a2[h * 64 + d];
    float run = 0.f;
    for (int tt = 0; tt < 16; ++tt) {
      const int tk = tg * 16 + tt;
      const float4* gp = (const float4*)(sV + tk * 16);
      float4 g0 = gp[0], g1 = gp[1], g2 = gp[2], g3 = gp[3];
      float z = bb + g0.x * wv[0] + g0.y * wv[1] + g0.z * wv[2] + g0.w * wv[3] + g1.x * wv[4] + g1.y * wv[5] + g1.z * wv[6] + g1.w * wv[7] +
                g2.x * wv[8] + g2.y * wv[9] + g2.z * wv[10] + g2.w * wv[11] + g3.x * wv[12] + g3.y * wv[13] + g3.z * wv[14] + g3.w * wv[15];
      float ls = fminf(z, 0.f) - __logf(1.f + __expf(-fabsf(z)));
      run += ls * (1.f / 16.f);
      sS[tk * GS + d] = run;
    }
    sV[2048 + tg * 64 + d] = run;
  }
  __syncthreads();
  if (tg > 0) {
    float off = 0.f;
    for (int q = 0; q < tg; ++q) off += sV[2048 + q * 64 + d];
    for (int tt = 0; tt < 16; ++tt) sS[(tg * 16 + tt) * GS + d] += off;
  }
  __syncthreads();
}

DI void gla_passA(const P& p, int item, char* smem) {
  float* sm = (float*)smem;
  u16* sKT = (u16*)sm;
  float* sV = sm + 4352;
  float* sS = sm + 13056;
  const u16* proj = (const u16*)(p.ws + W_PROJ);
  const int t = threadIdx.x & 255, lane = t & 63, w = t >> 6, l31 = lane & 31, hh = lane >> 5;
  int r0, h;
  const u16* vT;
  int vld;
  if (item < 4096) { int ch = item >> 7, c = item & 127; h = ch & 3; r0 = (ch >> 2) * 8192 + c * 64;
                     vT = (const u16*)(p.ws + W_GVT) + (size_t)ch * 128 * 8192 + c * 64; vld = 8192; }
  else { int j = item - 4096; h = j & 3; r0 = NPTOK + (j >> 2) * 64; vT = (const u16*)(p.ws + W_GVTS) + (size_t)j * 128 * 64; vld = 64; }
  gla_prep(p, proj, r0, h, sV, sS);
#pragma unroll
  for (int i = 0; i < 8; ++i) {
    int id = t + 256 * i, row = id >> 5, dp = id & 31;
    u32 kk = *(const u32*)(proj + (size_t)(r0 + row) * PROJ_LD + C_GK + h * 64 + dp * 2);
    float bl0 = sS[63 * GS + 2 * dp], bl1 = sS[63 * GS + 2 * dp + 1];
    float k0 = bflo(kk) * __expf(bl0 - sS[row * GS + 2 * dp]);
    float k1 = bfhi(kk) * __expf(bl1 - sS[row * GS + 2 * dp + 1]);
    u32 pk = pack2(k0, k1);
    const int pj = gperm(row);
    sKT[swz64(2 * dp, pj)] = (u16)(pk & 0xffffu);
    sKT[swz64(2 * dp + 1, pj)] = (u16)(pk >> 16);
  }
  bf16x8 af[4];
  const u16* vrow = vT + (size_t)(32 * w + l31) * vld + 8 * hh;
#pragma unroll
  for (int sx = 0; sx < 4; ++sx) af[sx] = *(const bf16x8*)(vrow + 16 * sx);
  __syncthreads();
  const f32x16 zero16 = {0.f, 0.f, 0.f, 0.f, 0.f, 0.f, 0.f, 0.f, 0.f, 0.f, 0.f, 0.f, 0.f, 0.f, 0.f, 0.f};
  f32x16 acc[2];
#pragma unroll
  for (int dt = 0; dt < 2; ++dt) {
    acc[dt] = zero16;
#pragma unroll
    for (int sx = 0; sx < 4; ++sx) {
      const bf16x8 bfg = *(const bf16x8*)(sKT + swz64(32 * dt + l31, 16 * sx + 8 * hh));
      acc[dt] = __builtin_amdgcn_mfma_f32_32x32x16_bf16(af[sx], bfg, acc[dt], 0, 0, 0);
    }
  }
  if (item < 4096) {
    float* Ub = (float*)(p.ws + W_U) + (size_t)item * 8192;
    float* db = (float*)(p.ws + W_DBUF) + (size_t)item * 64;
#pragma unroll
    for (int dt = 0; dt < 2; ++dt)
#pragma unroll
      for (int r = 0; r < 16; ++r) {
        const int e = 32 * w + (r & 3) + 8 * (r >> 2) + 4 * hh;
        Ub[e * 64 + 32 * dt + l31] = acc[dt][r];
      }
    if (t < 64) db[t] = expf(sS[63 * GS + t]);
  } else {
    const int j = item - 4096;
    const float* S0 = p.state_gla + (size_t)j * 8192;
    float* So = p.out + O_GLAS + (size_t)j * 8192;
#pragma unroll
    for (int dt = 0; dt < 2; ++dt) {
      const int d = 32 * dt + l31;
      const float dec = expf(sS[63 * GS + d]);
#pragma unroll
      for (int r = 0; r < 16; ++r) {
        const int e = 32 * w + (r & 3) + 8 * (r >> 2) + 4 * hh;
        So[d * 128 + e] = dec * S0[d * 128 + e] + acc[dt][r];
      }
    }
  }
  __syncthreads();
}

DI void gla_passB(const P& p) {
  float* Ub = (float*)(p.ws + W_U);
  const float* db = (const float*)(p.ws + W_DBUF);
  for (int e = blockIdx.x * 512 + threadIdx.x; e < 32 * 8192; e += gridDim.x * 512) {
    const int chain = e >> 13, ed = e & 8191, d = ed & 63, ee = ed >> 6;
    float S = 0.f;
    float* ub = Ub + (size_t)chain * 128 * 8192 + ed;
    const float* dd = db + (size_t)chain * 128 * 64 + d;
#pragma unroll 8
    for (int c = 0; c < 128; ++c) {
      float u = ub[(size_t)c * 8192];
      float dec = dd[c * 64];
      ub[(size_t)c * 8192] = S;
      S = dec * S + u;
    }
    p.out[O_GLAP + (size_t)chain * 8192 + d * 128 + ee] = S;
  }
}

template <int STOP = 0>
DI void gla_passC(const P& p, int item, char* smem) {
  float* sm = (float*)smem;
  u16* sQ = (u16*)sm;
  u16* sK = (u16*)(sm + 2048);
  float* red = sm + 4096;
  float* sV = sm + 4352;
  float* sS = sm + 13056;
  const u16* proj = (const u16*)(p.ws + W_PROJ);
  u16* mix = (u16*)(p.ws + W_H);
  const int t = threadIdx.x & 255, lane = t & 63, w = t >> 6, l31 = lane & 31, hh = lane >> 5;
  int r0, h, vld;
  const float* Ssrc;
  const u16* vT;
  const bool prompt = item < 4096;
  if (prompt) { int ch = item >> 7, c = item & 127; h = ch & 3; r0 = (ch >> 2) * 8192 + c * 64; Ssrc = (const float*)(p.ws + W_U) + (size_t)item * 8192;
                vT = (const u16*)(p.ws + W_GVT) + (size_t)ch * 128 * 8192 + c * 64; vld = 8192; }
  else { int j = item - 4096; h = j & 3; r0 = NPTOK + (j >> 2) * 64; Ssrc = p.state_gla + (size_t)j * 8192;
         vT = (const u16*)(p.ws + W_GVTS) + (size_t)j * 128 * 64; vld = 64; }
  gla_prep(p, proj, r0, h, sV, sS);
  if (STOP == 1) return;
#pragma unroll
  for (int i = 0; i < 8; ++i) {
    int id = t + 256 * i, row = id >> 5, dp = id & 31;
    u32 qq = *(const u32*)(proj + (size_t)(r0 + row) * PROJ_LD + C_GQ + h * 64 + dp * 2);
    u32 kk = *(const u32*)(proj + (size_t)(r0 + row) * PROJ_LD + C_GK + h * 64 + dp * 2);
    float b0 = sS[row * GS + 2 * dp], b1 = sS[row * GS + 2 * dp + 1];
    float e0 = __expf(b0), e1 = __expf(b1);
    *(u32*)(sQ + swz64(row, 2 * dp)) = pack2(bflo(qq) * 0.125f * e0, bfhi(qq) * 0.125f * e1);
    *(u32*)(sK + swz64(row, 2 * dp)) = pack2(bflo(kk) * __expf(-b0), bfhi(kk) * __expf(-b1));
  }
  __syncthreads();
  if (STOP == 2) return;
  const int it = w & 1, eh = w >> 1;
  const f32x16 zero16 = {0.f, 0.f, 0.f, 0.f, 0.f, 0.f, 0.f, 0.f, 0.f, 0.f, 0.f, 0.f, 0.f, 0.f, 0.f, 0.f};
  bf16x8 qfr[4];
#pragma unroll
  for (int sx = 0; sx < 4; ++sx) qfr[sx] = *(const bf16x8*)(sQ + swz64(32 * it + l31, 16 * sx + 8 * hh));
  f32x16 z0 = zero16, z1 = zero16;
  const u16* v0 = vT + (size_t)(64 * eh + l31) * vld + 8 * hh;
  const u16* v1 = v0 + (size_t)32 * vld;
#pragma unroll
  for (int jt = 0; jt < 2; ++jt) {
    if (jt <= it) {
      f32x16 x = zero16;
#pragma unroll
      for (int sx = 0; sx < 4; ++sx) {
        const bf16x8 kfr = *(const bf16x8*)(sK + swz64(32 * jt + l31, 16 * sx + 8 * hh));
        x = __builtin_amdgcn_mfma_f32_32x32x16_bf16(kfr, qfr[sx], x, 0, 0, 0);
      }
      if (jt == it) {
#pragma unroll
        for (int r = 0; r < 16; ++r) { const int jr = (r & 3) + 8 * (r >> 2) + 4 * hh; if (jr > l31) x[r] = 0.f; }
      }
#pragma unroll
      for (int sx = 0; sx < 2; ++sx) {
        const uint4 pk = {pack2(x[8 * sx], x[8 * sx + 1]), pack2(x[8 * sx + 2], x[8 * sx + 3]), pack2(x[8 * sx + 4], x[8 * sx + 5]), pack2(x[8 * sx + 6], x[8 * sx + 7])};
        const bf16x8 xa = __builtin_bit_cast(bf16x8, pk);
        const bf16x8 b0 = *(const bf16x8*)(v0 + 32 * jt + 16 * sx);
        const bf16x8 b1 = *(const bf16x8*)(v1 + 32 * jt + 16 * sx);
        z0 = __builtin_amdgcn_mfma_f32_32x32x16_bf16(xa, b0, z0, 0, 0, 0);
        z1 = __builtin_amdgcn_mfma_f32_32x32x16_bf16(xa, b1, z1, 0, 0, 0);
      }
    }
  }
#pragma unroll
  for (int sx = 0; sx < 4; ++sx) {
#pragma unroll
    for (int et = 0; et < 2; ++et) {
      const int e = 64 * eh + 32 * et + l31, d0 = 16 * sx + 8 * hh;
      float f[8];
      if (prompt) {
        const float4 a = *(const float4*)(Ssrc + e * 64 + d0), b = *(const float4*)(Ssrc + e * 64 + d0 + 4);
        f[0] = a.x; f[1] = a.y; f[2] = a.z; f[3] = a.w; f[4] = b.x; f[5] = b.y; f[6] = b.z; f[7] = b.w;
      } else {
#pragma unroll
        for (int q = 0; q < 8; ++q) f[q] = Ssrc[(d0 + q) * 128 + e];
      }
      const uint4 pk = {pack2(f[0], f[1]), pack2(f[2], f[3]), pack2(f[4], f[5]), pack2(f[6], f[7])};
      const bf16x8 sb = __builtin_bit_cast(bf16x8, pk);
      if (et == 0) z0 = __builtin_amdgcn_mfma_f32_32x32x16_bf16(qfr[sx], sb, z0, 0, 0, 0);
      else z1 = __builtin_amdgcn_mfma_f32_32x32x16_bf16(qfr[sx], sb, z1, 0, 0, 0);
    }
  }
  float rs[16];
#pragma unroll
  for (int r = 0; r < 16; ++r) {
    float ss = z0[r] * z0[r] + z1[r] * z1[r];
    ss += __shfl_xor(ss, 1); ss += __shfl_xor(ss, 2); ss += __shfl_xor(ss, 4); ss += __shfl_xor(ss, 8); ss += __shfl_xor(ss, 16);
    rs[r] = ss;
  }
#pragma unroll
  for (int r = 0; r < 16; ++r)
    if (l31 == r) red[(32 * it + (r & 3) + 8 * (r >> 2) + 4 * hh) * 2 + eh] = rs[r];
  __syncthreads();
  const float g0 = p.g_gla[64 * eh + l31], g1 = p.g_gla[64 * eh + 32 + l31];
#pragma unroll
  for (int r = 0; r < 16; ++r) {
    const int i = 32 * it + (r & 3) + 8 * (r >> 2) + 4 * hh;
    const float sst = red[i * 2] + red[i * 2 + 1];
    const float rstd = rsqrtf(sst * (1.f / 128.f) + EPS);
    const size_t row = (size_t)(r0 + i);
    const u16* ogp = proj + row * PROJ_LD + C_OG + h * 128 + 64 * eh + l31;
    u16* mp = mix + row * 1024 + 512 + h * 128 + 64 * eh + l31;
    const float og0 = __uint_as_float(((u32)ogp[0]) << 16), og1 = __uint_as_float(((u32)ogp[32]) << 16);
    mp[0] = (u16)(pack2(z0[r] * rstd * g0 * silu_f(og0), 0.f) & 0xffffu);
    mp[32] = (u16)(pack2(z1[r] * rstd * g1 * silu_f(og1), 0.f) & 0xffffu);
  }
  __syncthreads();
}

constexpr int KTB = 12288, VTB = 8192, ASTG = KTB + VTB;
#define AGLDS16(gp, lp) __builtin_amdgcn_global_load_lds((const unsigned*)(gp), (unsigned*)(lp), 16, 0, 0)
DI void attn_item(const P& p, int seq, int h, int qb, char* smem) {
  const u16* Qf = (const u16*)(p.ws + W_QF);
  const u16* Kf = (const u16*)(p.ws + W_KF);
  u16* mix = (u16*)(p.ws + W_H);
  const int t = threadIdx.x, lane = t & 63, wave = t >> 6, l31 = lane & 31, hh = lane >> 5;
  int ntiles, mylast, qtok0, Lk;
  const u16 *Kb, *Vb;
  if (seq < 8) {
    ntiles = qb * 4 + 4; mylast = qb * 4 + (wave >> 1); qtok0 = seq * 8192 + qb * 256 + wave * 32; Lk = 8192;
    Kb = Kf + ((size_t)h * G3ROWS + seq * 8192) * 96;
    Vb = (const u16*)(p.ws + W_VTP) + (size_t)((seq * 8 + h) * 64) * 8192;
  } else {
    ntiles = 17; mylast = (wave < 2) ? 16 : -1; qtok0 = NPTOK + (seq - 8) * 64 + (wave & 1) * 32; Lk = 1088;
    Kb = Kf + ((size_t)h * G3ROWS + NPTOK + (seq - 8) * 1088) * 96;
    Vb = (const u16*)(p.ws + W_VTS) + (size_t)(((seq - 8) * 8 + h) * 64) * 1088;
  }
  bf16x8 qf[6];
#pragma unroll
  for (int ks = 0; ks < 6; ++ks) {
    if (mylast >= 0) qf[ks] = *(const bf16x8*)(Qf + ((size_t)(qtok0 + l31) * 8 + h) * 96 + ks * 16 + hh * 8);
    else qf[ks] = bf16x8{0, 0, 0, 0, 0, 0, 0, 0};
  }
  const f32x16 zero16 = {0.f, 0.f, 0.f, 0.f, 0.f, 0.f, 0.f, 0.f, 0.f, 0.f, 0.f, 0.f, 0.f, 0.f, 0.f, 0.f};
  f32x16 o0 = zero16, o1 = zero16;
  float lsum = 0.f;
  const bool k2 = (t < 256);
  const int kid1 = k2 ? t + 512 : t;
  const int kr0 = t / 12, kp0 = t - kr0 * 12, kr1 = kid1 / 12, kp1 = kid1 - kr1 * 12;
  const int kg0 = kr0 * 96 + ((kp0 & ~3) | ((kp0 & 3) ^ ((kr0 >> 2) & 3))) * 8;
  const int kg1 = kr1 * 96 + ((kp1 & ~3) | ((kp1 & 3) ^ ((kr1 >> 2) & 3))) * 8;
  const int vd0 = t >> 3;
  const u16* vg0 = Vb + (size_t)vd0 * Lk + (((t & 7) ^ ((vd0 >> 1) & 7)) * 8);
  char* const lk0 = smem + t * 16;
  char* const lk1 = smem + kid1 * 16;
  char* const lv0 = smem + KTB + t * 16;
  const int kx = (l31 >> 2) & 3;
  const int koe = l31 * 96 + ((hh ^ kx) * 8), koo = l31 * 96 + (((2 + hh) ^ kx) * 8);
  const int vsw = (l31 >> 1) & 7;
#pragma unroll
  for (int i = 0; i < 3; ++i) {
    const u16* kg = Kb + (size_t)i * 6144;
    AGLDS16(kg + kg0, lk0 + i * ASTG);
    if (k2) AGLDS16(kg + kg1, lk1 + i * ASTG);
    AGLDS16(vg0 + i * 64, lv0 + i * ASTG);
  }
  __syncthreads();
  f32x16 sc = zero16;
  bf16x8 kfA[6], kfB[6];
#pragma unroll
  for (int ks = 0; ks < 6; ++ks) { kfA[ks] = bf16x8{0, 0, 0, 0, 0, 0, 0, 0}; kfB[ks] = kfA[ks]; }
  if (mylast >= 0) {
    const u16* Ks = (const u16*)smem;
#pragma unroll
    for (int ks = 0; ks < 6; ++ks) {
      bf16x8 kf = *(const bf16x8*)(Ks + ((ks & 1) ? koo : koe) + (ks >> 1) * 32);
      kfA[ks] = *(const bf16x8*)(Ks + 32 * 96 + ((ks & 1) ? koo : koe) + (ks >> 1) * 32);
      sc = __builtin_amdgcn_mfma_f32_32x32x16_bf16(kf, qf[ks], sc, 0, 0, 0);
    }
  }
  int st = 0;
  for (int kt = 0; kt < ntiles; ++kt) {
    const int st1 = (st + 1) & 3;
    const int st3 = (st + 3) & 3;
    if (kt + 3 < ntiles) {
      const u16* kg = Kb + (size_t)(kt + 3) * 6144;
      AGLDS16(kg + kg0, lk0 + st3 * ASTG);
      if (k2) AGLDS16(kg + kg1, lk1 + st3 * ASTG);
      AGLDS16(vg0 + (kt + 3) * 64, lv0 + st3 * ASTG);
    }
    if (kt <= mylast) {
      const u16* Vc = (const u16*)(smem + st * ASTG + KTB);
      const u16* Kn = (const u16*)(smem + st1 * ASTG);
#pragma unroll
      for (int sub = 0; sub < 2; ++sub) {
        bf16x8 vf0[2], vf1[2];
#pragma unroll
        for (int kk = 0; kk < 2; ++kk) {
          const int cl = ((sub * 2 + kk) * 2 + hh) ^ vsw;
          const u16* vp = Vc + l31 * 64 + cl * 8;
          vf0[kk] = *(const bf16x8*)(vp); vf1[kk] = *(const bf16x8*)(vp + 2048);
        }
#pragma unroll
        for (int ks = 0; ks < 6; ++ks) {
          const bf16x8 kx = *(const bf16x8*)(Kn + sub * 32 * 96 + ((ks & 1) ? koo : koe) + (ks >> 1) * 32);
          if (sub == 0) kfB[ks] = kx; else kfA[ks] = kx;
        }
        __builtin_amdgcn_sched_barrier(0);
        f32x16 sn = zero16;
#pragma unroll
        for (int ks = 0; ks < 6; ++ks) sn = __builtin_amdgcn_mfma_f32_32x32x16_bf16((sub == 0) ? kfA[ks] : kfB[ks], qf[ks], sn, 0, 0, 0);
        uint4 pk[2];
        {
          float ev[16];
#pragma unroll
          for (int e = 0; e < 16; ++e) { ev[e] = __builtin_amdgcn_exp2f(sc[e]); lsum += ev[e]; }
#pragma unroll
          for (int kk = 0; kk < 2; ++kk)
            pk[kk] = uint4{pack2(ev[8 * kk], ev[8 * kk + 1]), pack2(ev[8 * kk + 2], ev[8 * kk + 3]), pack2(ev[8 * kk + 4], ev[8 * kk + 5]), pack2(ev[8 * kk + 6], ev[8 * kk + 7])};
        }
#pragma unroll
        for (int kk = 0; kk < 2; ++kk) {
          const bf16x8 pp = __builtin_bit_cast(bf16x8, pk[kk]);
          o0 = __builtin_amdgcn_mfma_f32_32x32x16_bf16(vf0[kk], pp, o0, 0, 0, 0);
          o1 = __builtin_amdgcn_mfma_f32_32x32x16_bf16(vf1[kk], pp, o1, 0, 0, 0);
        }
        sc = sn;
        __builtin_amdgcn_sched_barrier(0);
      }
    }
    if (kt + 3 < ntiles) {
      if (k2) asm volatile("s_waitcnt vmcnt(3) lgkmcnt(0)" ::: "memory");
      else asm volatile("s_waitcnt vmcnt(2) lgkmcnt(0)" ::: "memory");
    } else {
      asm volatile("s_waitcnt vmcnt(0) lgkmcnt(0)" ::: "memory");
    }
    __builtin_amdgcn_s_barrier();
    asm volatile("" ::: "memory");
    st = st1;
  }
  if (mylast >= 0) {
    const float l = lsum + __shfl_xor(lsum, 32);
    const float inv = 1.f / l;
    const int tok = qtok0 + l31;
#pragma unroll
    for (int g = 0; g < 4; ++g) {
      const int vd = 8 * g + 4 * hh;
      uint2 w0 = {pack2(o0[4 * g] * inv, o0[4 * g + 1] * inv), pack2(o0[4 * g + 2] * inv, o0[4 * g + 3] * inv)};
      uint2 w1 = {pack2(o1[4 * g] * inv, o1[4 * g + 1] * inv), pack2(o1[4 * g + 2] * inv, o1[4 * g + 3] * inv)};
      *(uint2*)(mix + (size_t)tok * 1024 + h * 64 + vd) = w0;
      *(uint2*)(mix + (size_t)tok * 1024 + h * 64 + 32 + vd) = w1;
    }
  }
}

#ifndef MIX_SUB
#define MIX_SUB 3
#endif
template <int WHICH>
DI void mixer_phase(const P& p, char* smem) {
  const int G = gridDim.x, b = blockIdx.x;
  if (WHICH & MIX_SUB & 1) {
  for (int round = 0;; ++round) {
    int rank = round * G + ((round & 1) ? (G - 1 - b) : b);
    if (round * G >= 2048) break;
    if (rank < 2048) {
      int qb = 31 - (rank >> 6), bh = rank & 63;
      attn_item(p, bh >> 3, bh & 7, qb, smem);
    }
  }
  for (int it = G - 1 - b; it < 64; it += G) attn_item(p, 8 + (it >> 3), it & 7, 0, smem);
  }
  if (WHICH & MIX_SUB & 2)
  for (int it = 2 * b + (threadIdx.x >> 8); it < 4128; it += 2 * G) gla_passC(p, it, smem + (threadIdx.x >> 8) * 69632);
  if (WHICH & 4)
  for (int it = 2 * b + (threadIdx.x >> 8); it < 4128; it += 2 * G) gla_passC<1>(p, it, smem + (threadIdx.x >> 8) * 69632);
  if (WHICH & 8)
  for (int it = 2 * b + (threadIdx.x >> 8); it < 4128; it += 2 * G) gla_passC<2>(p, it, smem + (threadIdx.x >> 8) * 69632);
}

DI void fixup_phase(const P& p) {
  const float* first = (const float*)(p.ws + W_FIRST);
  const float* last = (const float*)(p.ws + W_LAST);
  u16* act = (u16*)(p.ws + W_ACT);
  for (int e = blockIdx.x * 512 + threadIdx.x; e < 1032 * 2816; e += gridDim.x * 512) {
    const int seg = e / 2816, ch = e - seg * 2816;
    float2 f0 = *(const float2*)(first + ((size_t)(seg * 2 + 0) * 2816 + ch) * 2);
    float2 f1 = *(const float2*)(first + ((size_t)(seg * 2 + 1) * 2816 + ch) * 2);
    float p0 = 0.f, p1 = 0.f;
    if (seg >= 1024) { p0 = p.state_conv[(size_t)((seg - 1024) * 2 + 0) * 2816 + ch]; p1 = p.state_conv[(size_t)((seg - 1024) * 2 + 1) * 2816 + ch]; }
    else if ((seg & 127) != 0) { p0 = last[(size_t)((seg - 1) * 2 + 0) * 2816 + ch]; p1 = last[(size_t)((seg - 1) * 2 + 1) * 2816 + ch]; }
    const float w0 = p.w_conv[ch], w1 = p.w_conv[2816 + ch], w2 = p.w_conv[5632 + ch], bb = p.b_conv[ch];
    float c0 = bb + w0 * p0 + w1 * p1 + w2 * f0.x;
    float c1 = bb + w0 * p1 + w1 * f0.x + w2 * f1.x;
    act[(size_t)(seg * 64) * 2816 + ch] = (u16)(pack2(gelu_tanh(c0) * f0.y, 0.f) & 0xffffu);
    act[(size_t)(seg * 64 + 1) * 2816 + ch] = (u16)(pack2(gelu_tanh(c1) * f1.y, 0.f) & 0xffffu);
  }
}

#ifndef ONLY_PH
#define ONLY_PH -1
#endif
#define PH_EN(n) (ONLY_PH < 0 || ONLY_PH == (n))
__global__ void __launch_bounds__(512, 2) mega(P p, int ph_lo, int ph_hi) {
  __shared__ __attribute__((aligned(16))) char smem[147456];
  cg::grid_group grid = cg::this_grid();
  const float* mods = (const float*)(p.ws + W_MODS);
  const float2* rope = (const float2*)(p.ws + W_ROPE);
#ifndef DUP_MASK
#define DUP_MASK 0
#endif
#define PHASE(n, ...) if (PH_EN(n) && ph_lo <= (n) && (n) <= ph_hi) { { __VA_ARGS__ } if ((DUP_MASK >> (n)) & 1) { __VA_ARGS__ } } if (ph_lo <= (n) && (n) < ph_hi) grid.sync();
  PHASE(0, phase0(p, smem);)
  PHASE(1, prenorm_phase(p, false, p.g_norm1, 0, 1);)
  PHASE(2, { EpiProj e{(u16*)(p.ws + W_PROJ), (u16*)(p.ws + W_GVT), (u16*)(p.ws + W_GVTS)};
             gemm_phase((const u16*)(p.ws + W_H), 1024, (const u16*)(p.ws + W_WIN), 1024, 258, 9, e, smem, 0); })
  PHASE(3, { rowlocal_phase(p);
             for (int it = 2 * blockIdx.x + (threadIdx.x >> 8); it < 4128; it += 2 * gridDim.x) gla_passA(p, it, smem + (threadIdx.x >> 8) * 69632); })
  PHASE(4, { EpiQ e{(u16*)(p.ws + W_QF), p.g_qn, rope};
             gemm_phase((const u16*)(p.ws + W_QN), 384, (const u16*)(p.ws + W_WUQ), 384, 258, 4, e, smem, 0);
             EpiKV e2{(u16*)(p.ws + W_KF), (u16*)(p.ws + W_VTP), (u16*)(p.ws + W_VTS), (const float*)(p.ws + W_KPE), p.g_kn, rope};
             gemm_phase((const u16*)(p.ws + W_CKVB), 256, (const u16*)(p.ws + W_WUKV), 256, 290, 4, e2, smem, 8);
             gla_passB(p); })
#ifndef PROBE_MIX
#define PROBE_MIX 0
#endif
  PHASE(5, if (PROBE_MIX) mixer_phase<PROBE_MIX>(p, smem); mixer_phase<3>(p, smem);)
  PHASE(6, { EpiRes e{&p, nullptr, (float*)(p.ws + W_X1), mods, 2};
             gemm_phase((const u16*)(p.ws + W_H), 1024, (const u16*)(p.ws + W_WOUT), 1024, 258, 4, e, smem, 0); })
  PHASE(7, prenorm_phase(p, true, p.g_norm2, 3, 4);)
#ifndef PROBE_MODE
#define PROBE_MODE 0
#endif
  PHASE(8, { EpiUp e{(u16*)(p.ws + W_ACT), (float*)(p.ws + W_FIRST), (float*)(p.ws + W_LAST), p.w_conv, p.b_conv, p.out};
             if (PROBE_MODE) gemm_phase<PROBE_MODE>((const u16*)(p.ws + W_H), 1024, (const u16*)(p.ws + W_WUP), 1024, 258, 22, e, smem, 0);
             gemm_phase((const u16*)(p.ws + W_H), 1024, (const u16*)(p.ws + W_WUP), 1024, 258, 22, e, smem, 0); })
  PHASE(9, fixup_phase(p);)
  PHASE(10, { EpiRes e{&p, (const float*)(p.ws + W_X1), p.out + O_Y, mods, 5};
              gemm_phase((const u16*)(p.ws + W_ACT), 2816, (const u16*)(p.ws + W_WDN), 2816, 258, 4, e, smem, 0); })
}

extern "C" void kernel_launch(void* const* d_in, const int* in_sizes, int n_in, void* d_out, int out_size, void* d_ws,
                              size_t ws_size, hipStream_t stream) {
  static int grid_blocks = 0;
  if (!grid_blocks) {
    int dev = 0, cus = 0, per_cu = 0;
    hipGetDevice(&dev);
    hipDeviceGetAttribute(&cus, hipDeviceAttributeMultiprocessorCount, dev);
    hipOccupancyMaxActiveBlocksPerMultiprocessor(&per_cu, mega, 512, 0);
    if (per_cu < 1) per_cu = 1;
    if (per_cu > 1) per_cu = 1;
    grid_blocks = cus * per_cu;
  }
  P p{};
  const float** f = (const float**)&p;
  for (int i = 0; i < 27; ++i) f[i] = (const float*)d_in[i];
  p.out = (float*)d_out;
  p.ws = (char*)d_ws;
  int lo = 0, hi = 10;
  void* args[] = {&p, &lo, &hi};
  hipError_t e = hipLaunchCooperativeKernel((void*)mega, dim3(grid_blocks), dim3(512), args, 0, stream);
  if (e != hipSuccess) fprintf(stderr, "cooperative launch failed: %s (grid %d)\n", hipGetErrorString(e), grid_blocks);
}
```
